# Optimizing an MI355X kernel written in HIP

```python
import math
import jax, jax.numpy as jnp
from jax import lax
import numpy as np

D_MODEL = 1024
BATCH = 4
SEQ = 4096
DEPTH = 2

POOL_WIDTH = 512
POOL_WINDOWS = (2, 4, 8, 16)
POOL_GROUPS = 4
POOL_GROUP_DIM = POOL_WIDTH // POOL_GROUPS
SGU_WIDTH = 512
SGU_CHUNK = 128
SGU_HEADS = 4
SGU_HEAD_DIM = SGU_WIDTH // SGU_HEADS
SSM_WIDTH = 512
SSM_GROUP_DIM = 16
SSM_GROUPS = SSM_WIDTH // SSM_GROUP_DIM
SSM_STATE = 64
N_BRANCHES = 3
BRANCH_WIDTH = 512
IN_COLS = POOL_WIDTH + 2 * SGU_WIDTH + SSM_WIDTH + N_BRANCHES * D_MODEL
N_GROUPS = 4
EXPERTS_PER_GROUP = 8
N_EXPERTS = N_GROUPS * EXPERTS_PER_GROUP
EXPERT_TOP_K = 2
D_EXPERT = D_MODEL // 2
EPS = 1e-6

kernel_name = "hybrid_pool_sgu_s5_hmoe"

F32 = jnp.float32


def rmsnorm(x, g):
    xf = x.astype(F32)
    y = xf * lax.rsqrt(jnp.mean(xf * xf, axis=-1, keepdims=True) + EPS)
    return (y * g.astype(F32)).astype(x.dtype)


def layernorm(x, g, b):
    xf = x.astype(F32)
    mu = jnp.mean(xf, axis=-1, keepdims=True)
    var = jnp.mean(jnp.square(xf - mu), axis=-1, keepdims=True)
    y = (xf - mu) * lax.rsqrt(var + EPS)
    return (y * g.astype(F32) + b.astype(F32)).astype(x.dtype)


def pool_mixer(xa, pool_w, pool_scale):
    B_, L, _ = xa.shape
    xf = xa.astype(F32)
    maxw = POOL_WINDOWS[-1]
    cs = jnp.cumsum(xf, axis=1)
    cp = jnp.pad(cs, ((0, 0), (maxw + 1, 0), (0, 0)))
    pos = jnp.arange(L)
    outs = []
    for gi, w in enumerate(POOL_WINDOWS):
        ch = slice(gi * POOL_GROUP_DIM, (gi + 1) * POOL_GROUP_DIM)
        count = jnp.minimum(pos + 1, w).astype(F32)[:, None]
        win_sum = cp[:, maxw + 1:maxw + 1 + L, ch] - cp[:, maxw + 1 - w:maxw + 1 - w + L, ch]
        outs.append(win_sum / count - xf[..., ch])
    diff = jnp.stack(outs, axis=2)
    y = jnp.einsum('blgc,gcd->blgd', diff, pool_w.astype(F32)).reshape(B_, L, POOL_WIDTH)
    return (y * pool_scale.astype(F32)).astype(xa.dtype)


def sgu_mixer(xb, ln_g, ln_b, w_s, b_s):
    z = jax.nn.gelu(xb)
    u, v = jnp.split(z, 2, axis=-1)
    v = layernorm(v, ln_g, ln_b)
    B_, L, _ = v.shape
    n_chunks = L // SGU_CHUNK
    v = v.reshape(B_, n_chunks, SGU_CHUNK, SGU_HEADS, SGU_HEAD_DIM)
    mask = jnp.tril(jnp.ones((SGU_CHUNK, SGU_CHUNK), dtype=bool))[None]
    w = jnp.where(mask, w_s, jnp.zeros_like(w_s))
    s = jnp.einsum('hts,bnshc->bnthc', w, v) + b_s.T[None, None, :, :, None]
    return u * s.reshape(B_, L, SGU_WIDTH)


def _ssm_combine(e1, e2):
    a1, b1 = e1
    a2, b2 = e2
    return a1 * a2, a2 * b1 + b2


def s5_mixer(xc, a_re, a_im, log_dt, b_re, b_im, c_re, c_im, d_skip, glu_w, glu_b):
    B_, L, _ = xc.shape
    lam = lax.complex(a_re.astype(F32), a_im.astype(F32))
    dt = jnp.exp(log_dt.astype(F32))[:, None]
    lam_bar = jnp.exp(lam * dt)
    b = lax.complex(b_re.astype(F32), b_im.astype(F32))
    b_bar = ((lam_bar - 1.0) / lam)[..., None] * b
    c = lax.complex(c_re.astype(F32), c_im.astype(F32))
    u = xc.astype(F32).reshape(B_, L, SSM_GROUPS, SSM_GROUP_DIM)
    bu = jnp.einsum('blgc,gpc->blgp', u.astype(jnp.complex64), b_bar)
    a = jnp.broadcast_to(lam_bar, bu.shape)
    _, states = lax.associative_scan(_ssm_combine, (a, bu), axis=1)
    y = jnp.einsum('blgp,gcp->blgc', states, c).real
    y = y + d_skip.astype(F32).reshape(SSM_GROUPS, SSM_GROUP_DIM) * u
    y = jax.nn.gelu(y.reshape(B_, L, SSM_WIDTH))
    y = y * jax.nn.sigmoid(y @ glu_w.astype(F32) + glu_b.astype(F32))
    return y.astype(xc.dtype)


def hier_moe(h, rg_w, rg_b, re_w, re_b, w_gate, w_up, w_down):
    B_, L, D = h.shape
    t = h.reshape(-1, D)
    g_logits = (t @ rg_w + rg_b).astype(F32)
    g_probs = jax.nn.softmax(g_logits, axis=-1)
    g_val, g_idx = lax.top_k(g_probs, 1)
    e_logits = (t @ re_w + re_b).astype(F32).reshape(-1, N_GROUPS, EXPERTS_PER_GROUP)
    e_sel = jnp.take_along_axis(e_logits, g_idx[:, :, None], axis=1)[:, 0]
    e_val, e_idx = lax.top_k(e_sel, EXPERT_TOP_K)
    e_w = jax.nn.softmax(e_val, axis=-1) * g_val
    global_idx = g_idx * EXPERTS_PER_GROUP + e_idx
    combine = jnp.einsum('tk,tke->te', e_w,
                         jax.nn.one_hot(global_idx, N_EXPERTS, dtype=F32)).astype(h.dtype)
    out = jnp.zeros_like(t)
    for e in range(N_EXPERTS):
        y = (jax.nn.silu(t @ w_gate[e]) * (t @ w_up[e])) @ w_down[e]
        out = out + combine[:, e:e + 1] * y
    return out.reshape(B_, L, D)


def setup_inputs(seed: int = 0) -> dict:
    key = jax.random.key(seed)
    ks = jax.random.split(key, 32)
    nrm = jax.random.normal
    D = D_MODEL
    G, P, C = SSM_GROUPS, SSM_STATE, SSM_GROUP_DIM
    x = nrm(ks[0], (BATCH, SEQ, D), F32)
    norm_mix_g = 1.0 + 0.02 * nrm(ks[1], (DEPTH, D), F32)
    w_in = nrm(ks[2], (DEPTH, D, IN_COLS), F32) * D ** -0.5
    b_gate = 0.02 * nrm(ks[3], (DEPTH, N_BRANCHES * D), F32)
    pool_w = nrm(ks[4], (DEPTH, POOL_GROUPS, POOL_GROUP_DIM, POOL_GROUP_DIM), F32) * POOL_GROUP_DIM ** -0.5
    pool_scale = 1.0 + 0.02 * nrm(ks[5], (DEPTH, POOL_WIDTH), F32)
    sgu_ln_g = 1.0 + 0.02 * nrm(ks[6], (DEPTH, SGU_WIDTH), F32)
    sgu_ln_b = 0.02 * nrm(ks[7], (DEPTH, SGU_WIDTH), F32)
    sgu_w = 0.5 * nrm(ks[8], (DEPTH, SGU_HEADS, SGU_CHUNK, SGU_CHUNK), F32) * SGU_CHUNK ** -0.5
    sgu_b = 1.0 + 0.02 * nrm(ks[9], (DEPTH, SGU_HEADS, SGU_CHUNK), F32)
    ssm_a_re = -0.5 + 0.01 * nrm(ks[10], (DEPTH, G, P), F32)
    ssm_a_im = math.pi * jnp.arange(P, dtype=F32)[None, None, :] + 0.01 * nrm(ks[11], (DEPTH, G, P), F32)
    ssm_log_dt = jax.random.uniform(ks[12], (DEPTH, G), F32, math.log(1e-3), math.log(1e-1))
    ssm_b_re = nrm(ks[13], (DEPTH, G, P, C), F32) * (0.5 / C) ** 0.5
    ssm_b_im = nrm(ks[14], (DEPTH, G, P, C), F32) * (0.5 / C) ** 0.5
    ssm_c_re = nrm(ks[15], (DEPTH, G, C, P), F32) * (0.5 / P) ** 0.5
    ssm_c_im = nrm(ks[16], (DEPTH, G, C, P), F32) * (0.5 / P) ** 0.5
    ssm_d = nrm(ks[17], (DEPTH, SSM_WIDTH), F32)
    glu_w = nrm(ks[18], (DEPTH, SSM_WIDTH, SSM_WIDTH), F32) * SSM_WIDTH ** -0.5
    glu_b = 0.02 * nrm(ks[19], (DEPTH, SSM_WIDTH), F32)
    w_branch = nrm(ks[20], (DEPTH, N_BRANCHES, BRANCH_WIDTH, D), F32) * BRANCH_WIDTH ** -0.5
    w_out = nrm(ks[21], (DEPTH, D, D), F32) * D ** -0.5
    norm_ffn_g = 1.0 + 0.02 * nrm(ks[22], (DEPTH, D), F32)
    router_group_w = nrm(ks[23], (DEPTH, D, N_GROUPS), F32) * D ** -0.5
    router_group_b = 0.01 * nrm(ks[24], (DEPTH, N_GROUPS), F32)
    router_expert_w = nrm(ks[25], (DEPTH, D, N_EXPERTS), F32) * D ** -0.5
    router_expert_b = 0.01 * nrm(ks[26], (DEPTH, N_EXPERTS), F32)
    exp_w_gate = nrm(ks[27], (DEPTH, N_EXPERTS, D, D_EXPERT), F32) * D ** -0.5
    exp_w_up = nrm(ks[28], (DEPTH, N_EXPERTS, D, D_EXPERT), F32) * D ** -0.5
    exp_w_down = nrm(ks[29], (DEPTH, N_EXPERTS, D_EXPERT, D), F32) * D_EXPERT ** -0.5
    norm_final_g = 1.0 + 0.02 * nrm(ks[30], (D,), F32)
    return {"x": x, "norm_mix_g": norm_mix_g, "w_in": w_in, "b_gate": b_gate,
            "pool_w": pool_w, "pool_scale": pool_scale,
            "sgu_ln_g": sgu_ln_g, "sgu_ln_b": sgu_ln_b, "sgu_w": sgu_w, "sgu_b": sgu_b,
            "ssm_a_re": ssm_a_re, "ssm_a_im": ssm_a_im, "ssm_log_dt": ssm_log_dt,
            "ssm_b_re": ssm_b_re, "ssm_b_im": ssm_b_im, "ssm_c_re": ssm_c_re, "ssm_c_im": ssm_c_im,
            "ssm_d": ssm_d, "glu_w": glu_w, "glu_b": glu_b,
            "w_branch": w_branch, "w_out": w_out, "norm_ffn_g": norm_ffn_g,
            "router_group_w": router_group_w, "router_group_b": router_group_b,
            "router_expert_w": router_expert_w, "router_expert_b": router_expert_b,
            "exp_w_gate": exp_w_gate, "exp_w_up": exp_w_up, "exp_w_down": exp_w_down,
            "norm_final_g": norm_final_g}


def reference(x, norm_mix_g, w_in, b_gate, pool_w, pool_scale, sgu_ln_g, sgu_ln_b, sgu_w, sgu_b,
              ssm_a_re, ssm_a_im, ssm_log_dt, ssm_b_re, ssm_b_im, ssm_c_re, ssm_c_im, ssm_d,
              glu_w, glu_b, w_branch, w_out, norm_ffn_g, router_group_w, router_group_b,
              router_expert_w, router_expert_b, exp_w_gate, exp_w_up, exp_w_down, norm_final_g):
    B_, L, D = x.shape
    a_end = POOL_WIDTH
    b_end = a_end + 2 * SGU_WIDTH
    c_end = b_end + SSM_WIDTH
    for l in range(DEPTH):
        h = rmsnorm(x, norm_mix_g[l])
        proj = h @ w_in[l]
        ya = pool_mixer(proj[..., :a_end], pool_w[l], pool_scale[l])
        yb = sgu_mixer(proj[..., a_end:b_end], sgu_ln_g[l], sgu_ln_b[l], sgu_w[l], sgu_b[l])
        yc = s5_mixer(proj[..., b_end:c_end], ssm_a_re[l], ssm_a_im[l], ssm_log_dt[l],
                      ssm_b_re[l], ssm_b_im[l], ssm_c_re[l], ssm_c_im[l], ssm_d[l],
                      glu_w[l], glu_b[l])
        ys = jnp.stack([ya, yb, yc], axis=2)
        branches = jnp.einsum('blkc,kcd->blkd', ys, w_branch[l])
        gates = jax.nn.sigmoid(proj[..., c_end:].reshape(B_, L, N_BRANCHES, D)
                               + b_gate[l].reshape(N_BRANCHES, D))
        merged = jnp.sum(gates * branches, axis=2)
        x = x + merged @ w_out[l]
        h2 = rmsnorm(x, norm_ffn_g[l])
        x = x + hier_moe(h2, router_group_w[l], router_group_b[l], router_expert_w[l],
                         router_expert_b[l], exp_w_gate[l], exp_w_up[l], exp_w_down[l])
    return rmsnorm(x, norm_final_g)
```

```cpp
#include <hip/hip_runtime.h>
#include <math.h>
#include <stdio.h>

namespace nv {
constexpr int T = 16384, D = 1024, SEQ = 4096, INC = 5120;
constexpr float EPS = 1e-6f;

__device__ __forceinline__ float gelu_tanh(float x) { return 0.5f * x * (1.0f + tanhf(0.7978845608028654f * (x + 0.044715f * x * x * x))); }
__device__ __forceinline__ float sigmoidf_(float x) { return 1.0f / (1.0f + expf(-x)); }

__device__ __forceinline__ float block_sum_256(float v, float* sh) {
    for (int o = 32; o >= 1; o >>= 1) v += __shfl_xor(v, o);
    __syncthreads();
    if ((threadIdx.x & 63) == 0) sh[threadIdx.x >> 6] = v;
    __syncthreads();
    return sh[0] + sh[1] + sh[2] + sh[3];
}

__global__ void __launch_bounds__(256) k_rmsnorm(const float* x, const float* g, float* out) {
    __shared__ float sh[8];
    const int t = blockIdx.x; const float* xr = x + (size_t)t * D;
    float v[4]; float ss = 0.f;
#pragma unroll
    for (int i = 0; i < 4; ++i) { v[i] = xr[threadIdx.x + 256 * i]; ss += v[i] * v[i]; }
    ss = block_sum_256(ss, sh);
    const float r = rsqrtf(ss / (float)D + EPS);
#pragma unroll
    for (int i = 0; i < 4; ++i) out[(size_t)t * D + threadIdx.x + 256 * i] = v[i] * r * g[threadIdx.x + 256 * i];
}

template <int MODE>
__global__ void __launch_bounds__(256) k_sgemm(const float* A, int lda, const float* B, int ldb, float* C, int ldc,
                                               const float* R, int ldr, const float* bias, int first, int K) {
    __shared__ float As[16][68];
    __shared__ float Bs[16][64];
    const int tx = threadIdx.x & 15, ty = threadIdx.x >> 4;
    const int m0 = blockIdx.y * 64, n0 = blockIdx.x * 64;
    float acc[4][4];
#pragma unroll
    for (int i = 0; i < 4; ++i)
#pragma unroll
        for (int j = 0; j < 4; ++j) acc[i][j] = 0.f;
    for (int k0 = 0; k0 < K; k0 += 16) {
        { const int r = threadIdx.x >> 2, c = (threadIdx.x & 3) * 4;
          const float4 a = *(const float4*)&A[(size_t)(m0 + r) * lda + k0 + c];
          As[c + 0][r] = a.x; As[c + 1][r] = a.y; As[c + 2][r] = a.z; As[c + 3][r] = a.w; }
        { const int r = threadIdx.x >> 4, c = (threadIdx.x & 15) * 4;
          *(float4*)&Bs[r][c] = *(const float4*)&B[(size_t)(k0 + r) * ldb + n0 + c]; }
        __syncthreads();
#pragma unroll
        for (int kk = 0; kk < 16; ++kk) {
            float a[4], b[4];
#pragma unroll
            for (int i = 0; i < 4; ++i) a[i] = As[kk][ty * 4 + i];
#pragma unroll
            for (int j = 0; j < 4; ++j) b[j] = Bs[kk][tx * 4 + j];
#pragma unroll
            for (int i = 0; i < 4; ++i)
#pragma unroll
                for (int j = 0; j < 4; ++j) acc[i][j] += a[i] * b[j];
        }
        __syncthreads();
    }
#pragma unroll
    for (int i = 0; i < 4; ++i)
#pragma unroll
        for (int j = 0; j < 4; ++j) {
            const int m = m0 + ty * 4 + i, n = n0 + tx * 4 + j;
            float* cp = C + (size_t)m * ldc + n;
            if (MODE == 0) *cp = acc[i][j];
            if (MODE == 1) *cp = R[(size_t)m * ldr + n] + acc[i][j];
            if (MODE == 2) *cp = R[(size_t)m * ldr + n] * sigmoidf_(acc[i][j] + bias[n]);
            if (MODE == 3) { const float g = sigmoidf_(R[(size_t)m * ldr + n] + bias[n]); *cp = (first ? 0.f : *cp) + g * acc[i][j]; }
        }
}

__global__ void __launch_bounds__(256) k_pool_diff(const float* proj, float* diff) {
    const int idx = blockIdx.x * 256 + threadIdx.x; const int t = idx >> 9, ch = idx & 511, g = ch >> 7;
    const int w = 2 << g; const int pos = t & (SEQ - 1); const int cnt = (pos + 1 < w) ? pos + 1 : w;
    float s = 0.f;
    for (int j = 0; j < cnt; ++j) s += proj[(size_t)(t - j) * INC + ch];
    diff[idx] = s / (float)cnt - proj[(size_t)t * INC + ch];
}
__global__ void __launch_bounds__(256) k_pool_mm(const float* diff, const float* pw, const float* scale, float* out, int ldo) {
    const int idx = blockIdx.x * 256 + threadIdx.x; const int t = idx >> 9, ch = idx & 511, g = ch >> 7, d = ch & 127;
    const float* dr = diff + (size_t)t * 512 + g * 128; const float* w = pw + (size_t)g * 128 * 128 + d;
    float s = 0.f;
    for (int c = 0; c < 128; ++c) s += dr[c] * w[c * 128];
    out[(size_t)t * ldo + ch] = s * scale[ch];
}
__global__ void __launch_bounds__(256) k_sgu_prep(float* proj, const float* lng, const float* lnb) {
    __shared__ float sh[8];
    const int t = blockIdx.x; float* row = proj + (size_t)t * INC;
    float v[2]; float s = 0.f;
#pragma unroll
    for (int i = 0; i < 2; ++i) { const int c = threadIdx.x + 256 * i; row[512 + c] = gelu_tanh(row[512 + c]); v[i] = gelu_tanh(row[1024 + c]); s += v[i]; }
    s = block_sum_256(s, sh); const float mu = s / 512.f;
    float q = 0.f;
#pragma unroll
    for (int i = 0; i < 2; ++i) { const float dd = v[i] - mu; q += dd * dd; }
    q = block_sum_256(q, sh); const float rs = rsqrtf(q / 512.f + EPS);
#pragma unroll
    for (int i = 0; i < 2; ++i) { const int c = threadIdx.x + 256 * i; row[1024 + c] = (v[i] - mu) * rs * lng[c] + lnb[c]; }
}
__global__ void __launch_bounds__(256) k_sgu_mix(float* proj, const float* w, const float* bs) {
    const int idx = blockIdx.x * 256 + threadIdx.x; const int t = idx >> 9, ch = idx & 511, h = ch >> 7;
    const int tl = t & 127, cb = t - tl;
    const float* wr = w + ((size_t)h * 128 + tl) * 128;
    float s = 0.f;
    for (int sp = 0; sp <= tl; ++sp) s += wr[sp] * proj[(size_t)(cb + sp) * INC + 1024 + ch];
    s += bs[h * 128 + tl];
    proj[(size_t)t * INC + 512 + ch] *= s;
}
__global__ void __launch_bounds__(64) k_s5_scan(float* proj, const float* a_re, const float* a_im, const float* log_dt, const float* b_re, const float* b_im,
                                                const float* c_re, const float* c_im, const float* dskip) {
    const int b = blockIdx.x >> 5, g = blockIdx.x & 31, p = threadIdx.x;
    const float lre = a_re[g * 64 + p], lim = a_im[g * 64 + p], dt = expf(log_dt[g]);
    const float er = expf(lre * dt); const float lbr = er * cosf(lim * dt), lbi = er * sinf(lim * dt);
    const float nr = lbr - 1.f, ni = lbi, den = lre * lre + lim * lim;
    const float cr = (nr * lre + ni * lim) / den, ci = (ni * lre - nr * lim) / den;
    float bbr[16], bbi[16], ccr[16], cci[16];
#pragma unroll
    for (int c = 0; c < 16; ++c) {
        const float br = b_re[(g * 64 + p) * 16 + c], bi = b_im[(g * 64 + p) * 16 + c];
        bbr[c] = cr * br - ci * bi; bbi[c] = cr * bi + ci * br;
        ccr[c] = c_re[(g * 16 + c) * 64 + p]; cci[c] = c_im[(g * 16 + c) * 64 + p];
    }
    const float dsk = dskip[g * 16 + (p & 15)];
    float xr = 0.f, xi = 0.f;
    for (int t = 0; t < SEQ; ++t) {
        float* row = proj + (size_t)(b * SEQ + t) * INC + 1536 + g * 16;
        float u[16];
#pragma unroll
        for (int c = 0; c < 16; ++c) u[c] = row[c];
        float bur = 0.f, bui = 0.f;
#pragma unroll
        for (int c = 0; c < 16; ++c) { bur += bbr[c] * u[c]; bui += bbi[c] * u[c]; }
        const float nxr = lbr * xr - lbi * xi + bur, nxi = lbr * xi + lbi * xr + bui; xr = nxr; xi = nxi;
        float yout = 0.f;
#pragma unroll
        for (int c = 0; c < 16; ++c) {
            float v = xr * ccr[c] - xi * cci[c];
            for (int o = 32; o >= 1; o >>= 1) v += __shfl_xor(v, o);
            if (p == c) yout = v + dsk * u[c];
        }
        __syncthreads();
        if (p < 16) row[p] = gelu_tanh(yout);
    }
}

__global__ void __launch_bounds__(256) k_moe(float* x, const float* gn, const float* rgw, const float* rgb, const float* rew, const float* reb,
                                             const float* wg, const float* wu, const float* wd) {
    __shared__ float h[1024]; __shared__ float logits[36]; __shared__ float act[512]; __shared__ float sh[8];
    const int t = blockIdx.x, tid = threadIdx.x; float* xr = x + (size_t)t * D;
    float v[4]; float ss = 0.f;
#pragma unroll
    for (int i = 0; i < 4; ++i) { v[i] = xr[tid + 256 * i]; ss += v[i] * v[i]; }
    ss = block_sum_256(ss, sh);
    const float r = rsqrtf(ss / (float)D + EPS);
#pragma unroll
    for (int i = 0; i < 4; ++i) h[tid + 256 * i] = v[i] * r * gn[tid + 256 * i];
    __syncthreads();
    if (tid < 36) {
        float s = 0.f;
        if (tid < 4) { for (int k = 0; k < D; ++k) s += h[k] * rgw[k * 4 + tid]; s += rgb[tid]; }
        else { const int j = tid - 4; for (int k = 0; k < D; ++k) s += h[k] * rew[k * 32 + j]; s += reb[j]; }
        logits[tid] = s;
    }
    __syncthreads();
    int gi = 0; float gm = logits[0];
    for (int j = 1; j < 4; ++j) if (logits[j] > gm) { gm = logits[j]; gi = j; }
    float gs = 0.f; for (int j = 0; j < 4; ++j) gs += expf(logits[j] - gm);
    const float gval = 1.0f / gs;
    int i0 = 0; float v0 = logits[4 + gi * 8];
    for (int j = 1; j < 8; ++j) { const float e = logits[4 + gi * 8 + j]; if (e > v0) { v0 = e; i0 = j; } }
    int i1 = -1; float v1 = -INFINITY;
    for (int j = 0; j < 8; ++j) { if (j == i0) continue; const float e = logits[4 + gi * 8 + j]; if (e > v1) { v1 = e; i1 = j; } }
    const float e1 = expf(v1 - v0); const float w0 = gval / (1.f + e1), w1 = gval * e1 / (1.f + e1);
    float outacc[4] = {0.f, 0.f, 0.f, 0.f};
    for (int slot = 0; slot < 2; ++slot) {
        const int e = gi * 8 + (slot == 0 ? i0 : i1); const float wgt = slot == 0 ? w0 : w1;
        const float* Wg = wg + (size_t)e * 1024 * 512; const float* Wu = wu + (size_t)e * 1024 * 512; const float* Wd = wd + (size_t)e * 512 * 1024;
        for (int n = tid; n < 512; n += 256) {
            float a = 0.f, b = 0.f;
            for (int k = 0; k < D; ++k) { const float hk = h[k]; a += hk * Wg[(size_t)k * 512 + n]; b += hk * Wu[(size_t)k * 512 + n]; }
            act[n] = (a / (1.f + expf(-a))) * b;
        }
        __syncthreads();
#pragma unroll
        for (int j = 0; j < 4; ++j) { const int d = tid + 256 * j; float s = 0.f; for (int n = 0; n < 512; ++n) s += act[n] * Wd[(size_t)n * 1024 + d]; outacc[j] += wgt * s; }
        __syncthreads();
    }
#pragma unroll
    for (int j = 0; j < 4; ++j) xr[tid + 256 * j] = v[j] + outacc[j];
}
}

extern "C" void kernel_launch(void* const* d_in, const int* in_sizes, int n_in, void* d_out, int out_size, void* d_ws, size_t ws_size, hipStream_t stream) {
    using namespace nv;
    const size_t need = (size_t)T * (D + INC + 512) * 4;
    if (n_in != 31 || out_size != T * D || ws_size < need) { fprintf(stderr, "kernel_launch: unexpected shapes (n_in %d out %d ws %zu need %zu)\n", n_in, out_size, ws_size, need); return; }
    const float* const* in = (const float* const*)d_in;
    float* X = (float*)d_out;
    float* H = (float*)d_ws;
    float* PROJ = H + (size_t)T * D;
    float* DIFF = PROJ + (size_t)T * INC;
    hipMemcpyAsync(X, in[0], (size_t)T * D * 4, hipMemcpyDeviceToDevice, stream);
    for (int l = 0; l < 2; ++l) {
        const float* norm_mix_g = in[1] + l * D; const float* w_in = in[2] + (size_t)l * D * INC; const float* b_gate = in[3] + l * 3 * D;
        const float* pool_w = in[4] + (size_t)l * 4 * 128 * 128; const float* pool_scale = in[5] + l * 512;
        const float* ln_g = in[6] + l * 512; const float* ln_b = in[7] + l * 512; const float* sgu_w = in[8] + (size_t)l * 4 * 128 * 128; const float* sgu_b = in[9] + l * 512;
        const float* a_re = in[10] + l * 2048; const float* a_im = in[11] + l * 2048; const float* log_dt = in[12] + l * 32;
        const float* b_re = in[13] + l * 32768; const float* b_im = in[14] + l * 32768; const float* c_re = in[15] + l * 32768; const float* c_im = in[16] + l * 32768;
        const float* ssm_d = in[17] + l * 512; const float* glu_w = in[18] + (size_t)l * 512 * 512; const float* glu_b = in[19] + l * 512;
        const float* w_branch = in[20] + (size_t)l * 3 * 512 * 1024; const float* w_out = in[21] + (size_t)l * D * D; const float* norm_ffn_g = in[22] + l * D;
        const float* rgw = in[23] + l * D * 4; const float* rgb = in[24] + l * 4; const float* rew = in[25] + l * D * 32; const float* reb = in[26] + l * 32;
        const float* wg = in[27] + (size_t)l * 32 * 1024 * 512; const float* wu = in[28] + (size_t)l * 32 * 1024 * 512; const float* wd = in[29] + (size_t)l * 32 * 512 * 1024;

        k_rmsnorm<<<T, 256, 0, stream>>>(X, norm_mix_g, H);
        k_sgemm<0><<<dim3(INC / 64, T / 64), 256, 0, stream>>>(H, D, w_in, INC, PROJ, INC, nullptr, 0, nullptr, 0, D);
        k_pool_diff<<<T * 512 / 256, 256, 0, stream>>>(PROJ, DIFF);
        k_pool_mm<<<T * 512 / 256, 256, 0, stream>>>(DIFF, pool_w, pool_scale, PROJ, INC);
        k_sgu_prep<<<T, 256, 0, stream>>>(PROJ, ln_g, ln_b);
        k_sgu_mix<<<T * 512 / 256, 256, 0, stream>>>(PROJ, sgu_w, sgu_b);
        k_s5_scan<<<4 * 32, 64, 0, stream>>>(PROJ, a_re, a_im, log_dt, b_re, b_im, c_re, c_im, ssm_d);
        k_sgemm<2><<<dim3(512 / 64, T / 64), 256, 0, stream>>>(PROJ + 1536, INC, glu_w, 512, PROJ + 1024, INC, PROJ + 1536, INC, glu_b, 0, 512);
        for (int k = 0; k < 3; ++k)
            k_sgemm<3><<<dim3(D / 64, T / 64), 256, 0, stream>>>(PROJ + k * 512, INC, w_branch + (size_t)k * 512 * D, D, H, D, PROJ + 2048 + k * D, INC, b_gate + k * D, k == 0, 512);
        k_sgemm<1><<<dim3(D / 64, T / 64), 256, 0, stream>>>(H, D, w_out, D, X, D, X, D, nullptr, 0, D);
        k_moe<<<T, 256, 0, stream>>>(X, norm_ffn_g, rgw, rgb, rew, reb, wg, wu, wd);
    }
    k_rmsnorm<<<T, 256, 0, stream>>>(X, in[30], X);
}
```

```cpp
#include <hip/hip_runtime.h>
#include <math.h>
#include <stdio.h>

#ifndef FAST_MASK
#define FAST_MASK 0x45E4u
#endif
#ifndef ONE_LAUNCH
#define ONE_LAUNCH 0
#endif

#define LAS __attribute__((address_space(3)))
typedef unsigned short bf16_t;
typedef short bf16x8 __attribute__((ext_vector_type(8)));
typedef float f32x4 __attribute__((ext_vector_type(4)));
typedef float f32x2 __attribute__((ext_vector_type(2)));
typedef unsigned u32x4 __attribute__((ext_vector_type(4)));
typedef unsigned u32x2 __attribute__((ext_vector_type(2)));

constexpr int T = 16384, D = 1024, SEQ = 4096, INC = 5120, NE = 32, DE = 512;
constexpr int QC = 32;
constexpr int NCH = T / QC;
constexpr int UGLD = 640;
constexpr float EPS = 1e-6f;
constexpr int CAP = 32768;
constexpr int NTHREADS = 512;
constexpr int LDS_BYTES = 155648;

constexpr size_t MiB = 1u << 20;
constexpr size_t WS_CTL = 0;
constexpr size_t WS_WIN = 1 * MiB;
constexpr size_t WS_WB = WS_WIN + 10 * MiB;
constexpr size_t WS_WOUT = WS_WB + 3 * MiB;
constexpr size_t WS_GLU = WS_WOUT + 2 * MiB;
constexpr size_t WS_SGW = WS_GLU + MiB / 2;
constexpr size_t WS_ET = WS_SGW + MiB / 2;
constexpr size_t WS_TZF = WS_ET + 8 * MiB;
constexpr size_t WS_WGU = WS_TZF + 20 * MiB;
constexpr size_t WS_WD = WS_WGU + 64 * MiB;
constexpr size_t WS_HB = WS_WD + 32 * MiB;
constexpr size_t WS_PA = WS_HB + 32 * MiB;
constexpr size_t WS_UV = WS_PA + 16 * MiB;
constexpr size_t WS_UG = WS_UV + 32 * MiB;
constexpr size_t WS_YG = WS_UG + 20 * MiB;
constexpr size_t WS_SST = WS_YG + 16 * MiB;
constexpr size_t WS_MERGED = WS_SST + 8 * MiB;
constexpr size_t WS_GATES = WS_MERGED + 32 * MiB;
constexpr size_t WS_YS = WS_GATES + 96 * MiB;
constexpr size_t WS_END = WS_YS + 48 * MiB;
constexpr size_t WS_LIST = WS_GATES;
constexpr size_t WS_LW = WS_LIST + 4 * MiB;
constexpr size_t WS_ACT = WS_LW + 4 * MiB;
constexpr size_t WS_YB = WS_ACT + 40 * MiB;
static_assert(WS_YB + 64 * MiB <= WS_END, "moe overlay");
constexpr int CW_BAR = 0;
constexpr int CW_CNT = 8192;

struct Params {
    const float* in[31];
    float* out;
    unsigned char* ws;
};

__device__ __forceinline__ unsigned cvt_pk_bf16(float lo, float hi) { unsigned r; asm volatile("v_cvt_pk_bf16_f32 %0, %1, %2" : "=v"(r) : "v"(lo), "v"(hi)); return r; }
__device__ __forceinline__ bf16_t f2bf(float f) { return (bf16_t)(cvt_pk_bf16(f, 0.f) & 0xffffu); }
__device__ __forceinline__ float bf2f(bf16_t b) { return __uint_as_float(((unsigned)b) << 16); }
__device__ __forceinline__ float bflo(unsigned w) { return __uint_as_float(w << 16); }
__device__ __forceinline__ float bfhi(unsigned w) { return __uint_as_float(w & 0xffff0000u); }
__device__ __forceinline__ float fast_sigmoid(float x) { return __builtin_amdgcn_rcpf(1.0f + __builtin_amdgcn_exp2f(-1.4426950408889634f * x)); }
__device__ __forceinline__ float gelu_tanh_fast(float x) { const float z = 1.5957691216057308f * (x + 0.044715f * x * x * x); return x * fast_sigmoid(z); }
__device__ __forceinline__ float gelu_tanh_ref(float x) { return 0.5f * x * (1.0f + tanhf(0.7978845608028654f * (x + 0.044715f * x * x * x))); }
__device__ __forceinline__ float wave_sum(float v) { for (int o = 32; o >= 1; o >>= 1) v += __shfl_xor(v, o); return v; }
__device__ __forceinline__ unsigned ld_agent(const unsigned* p) { return __hip_atomic_load(p, __ATOMIC_RELAXED, __HIP_MEMORY_SCOPE_AGENT); }

struct LayerPtrs {
    const float *norm_mix_g, *w_in, *b_gate, *pool_w, *pool_scale, *ln_g, *ln_b, *sgu_w, *sgu_b, *a_re, *a_im, *log_dt, *b_re, *b_im, *c_re, *c_im, *ssm_d, *glu_w, *glu_b,
        *w_branch, *w_out, *norm_ffn_g, *rgw, *rgb, *rew, *reb, *wg, *wu, *wd;
};
__device__ __host__ __forceinline__ LayerPtrs layer_ptrs(const Params& p, int l) {
    LayerPtrs q;
    q.norm_mix_g = p.in[1] + l * D; q.w_in = p.in[2] + (size_t)l * D * INC; q.b_gate = p.in[3] + l * 3 * D;
    q.pool_w = p.in[4] + (size_t)l * 4 * 128 * 128; q.pool_scale = p.in[5] + l * 512;
    q.ln_g = p.in[6] + l * 512; q.ln_b = p.in[7] + l * 512; q.sgu_w = p.in[8] + (size_t)l * 4 * 128 * 128; q.sgu_b = p.in[9] + l * 512;
    q.a_re = p.in[10] + l * 2048; q.a_im = p.in[11] + l * 2048; q.log_dt = p.in[12] + l * 32;
    q.b_re = p.in[13] + l * 32768; q.b_im = p.in[14] + l * 32768; q.c_re = p.in[15] + l * 32768; q.c_im = p.in[16] + l * 32768;
    q.ssm_d = p.in[17] + l * 512; q.glu_w = p.in[18] + (size_t)l * 512 * 512; q.glu_b = p.in[19] + l * 512;
    q.w_branch = p.in[20] + (size_t)l * 3 * 512 * 1024; q.w_out = p.in[21] + (size_t)l * D * D; q.norm_ffn_g = p.in[22] + l * D;
    q.rgw = p.in[23] + l * D * 4; q.rgb = p.in[24] + l * 4; q.rew = p.in[25] + l * D * 32; q.reb = p.in[26] + l * 32;
    q.wg = p.in[27] + (size_t)l * NE * D * DE; q.wu = p.in[28] + (size_t)l * NE * D * DE; q.wd = p.in[29] + (size_t)l * NE * DE * D;
    return q;
}
#define WSP(type, off) ((type*)(p.ws + (off)))

namespace pg8 {
constexpr int BM = 256, BK = 64, HALF = 128, HTB = HALF * BK * 2, STAGE_BYTES = 8 * HTB;
__host__ __device__ __forceinline__ int lds_byte(int r, int c) { const int st = (r >> 4) * 2 + (c >> 5), rr = r & 15, cc = c & 31, ob = rr * 64 + cc * 2; return st * 1024 + (ob ^ (((ob >> 9) & 1) << 5)); }
__host__ __device__ __forceinline__ void stage_rc(int b, int& R, int& C) { const int st = b / 1024, sb = b % 1024, swz = sb ^ (((sb >> 9) & 1) << 5); R = (st >> 1) * 16 + swz / 64; C = (st & 1) * 32 + (swz % 64) / 2; }
__host__ __device__ __forceinline__ int perm32(int rho) { const int n = rho >> 4, i = rho & 15; return 8 * (i >> 2) + 4 * n + (i & 3); }
struct Unit { int pm, pn, e, p0, nvalid, prow, sub; };
template <class Epi, class Sched, bool ALIGN_EPI = true>
__device__ __forceinline__ void gemm_phase(LAS unsigned char* lds, const Sched& S, const Epi& E) {
    const int tid = threadIdx.x, wid = __builtin_amdgcn_readfirstlane(tid >> 6), lane = tid & 63, wr = wid >> 2, wc = wid & 3, fr = lane & 15, fq = lane >> 4;
    const int nt = S.K / BK;
    int R0, C0, R1, C1; stage_rc(tid * 16, R0, C0); stage_rc(tid * 16 + 8192, R1, C1);
    const int Rb0 = Epi::PERM ? ((R0 & ~31) + perm32(R0 & 31)) : R0, Rb1 = Epi::PERM ? ((R1 & ~31) + perm32(R1 & 31)) : R1;
    const unsigned vB0 = (unsigned)(Rb0 * S.ldb + C0) * 2u, vB1 = (unsigned)(Rb1 * S.ldb + C1) * 2u;
    const size_t kstep = (size_t)(BK * 2);
    const size_t hstepB = (size_t)HALF * S.ldb * 2;
    const unsigned ldsw = (unsigned)wid * 1024u;
    const int aoff = lds_byte(wr * 64 + fr, fq * 8), boff = lds_byte(wc * 32 + fr, fq * 8);
#define PG8_SA(b, h) (((b) * 2 + (h)) * HTB)
#define PG8_SB(b, h) ((4 + (b) * 2 + (h)) * HTB)
#define PG8_STAGE2(bufoff, gbase, o0, o1) do { \
        __builtin_amdgcn_global_load_lds((const unsigned*)((const char*)(gbase) + (o0)), (LAS unsigned*)(lds + (bufoff) + ldsw), 16, 0, 0); \
        __builtin_amdgcn_global_load_lds((const unsigned*)((const char*)(gbase) + (o1)), (LAS unsigned*)(lds + (bufoff) + ldsw + 8192), 16, 0, 0); } while (0)
#define PG8_LDA(dst, b, h) do { _Pragma("unroll") for (int m = 0; m < 4; ++m) _Pragma("unroll") for (int k = 0; k < 2; ++k) dst[m][k] = *(const LAS bf16x8*)(lds + PG8_SA(b, h) + aoff + m * 2048 + k * 1024); } while (0)
#define PG8_LDB(dst, b, h) do { _Pragma("unroll") for (int n = 0; n < 2; ++n) _Pragma("unroll") for (int k = 0; k < 2; ++k) dst[n][k] = *(const LAS bf16x8*)(lds + PG8_SB(b, h) + boff + n * 2048 + k * 1024); } while (0)
#define PG8_MMA(ai, bj, At, Bt) do { __builtin_amdgcn_s_setprio(1); _Pragma("unroll") for (int m = 0; m < 4; ++m) _Pragma("unroll") for (int n = 0; n < 2; ++n) _Pragma("unroll") for (int k = 0; k < 2; ++k) \
        acc[ai][bj][m][n] = __builtin_amdgcn_mfma_f32_16x16x32_bf16(Bt[n][k], At[m][k], acc[ai][bj][m][n], 0, 0, 0); __builtin_amdgcn_s_setprio(0); } while (0)
#define PG8_WAIT_V(n) asm volatile("s_waitcnt vmcnt(" #n ")" ::: "memory")
#define PG8_WAIT_L(n) asm volatile("s_waitcnt lgkmcnt(" #n ")" ::: "memory")
#define PG8_BAR __builtin_amdgcn_s_barrier()
#define PG8_SCHED __builtin_amdgcn_sched_barrier(0)
    Unit cur, nxt; int ui = 0;
    if (!S.next(0, cur)) return;
    f32x4 acc[2][2][4][2];
#pragma unroll
    for (int a = 0; a < 2; ++a)
#pragma unroll
        for (int b = 0; b < 2; ++b)
#pragma unroll
            for (int m = 0; m < 4; ++m)
#pragma unroll
                for (int n = 0; n < 2; ++n) acc[a][b][m][n] = (f32x4){0.f, 0.f, 0.f, 0.f};
    bf16x8 At[4][2], B0[2][2], B1[2][2];
    const char* cA = S.a_base(cur); const char* cB = S.b_base(cur);
    unsigned c00 = S.a_off(cur, R0, C0), c01 = S.a_off(cur, R1, C1), c10 = S.a_off(cur, HALF + R0, C0), c11 = S.a_off(cur, HALF + R1, C1);
    PG8_STAGE2(PG8_SB(0, 0), cB, vB0, vB1); PG8_STAGE2(PG8_SB(0, 1), cB + hstepB, vB0, vB1); PG8_STAGE2(PG8_SA(0, 0), cA, c00, c01); PG8_STAGE2(PG8_SA(0, 1), cA, c10, c11);
    if (wr == 1) PG8_BAR;
    PG8_WAIT_V(2); PG8_BAR;
    PG8_STAGE2(PG8_SB(1, 0), cB + kstep, vB0, vB1); PG8_STAGE2(PG8_SA(1, 0), cA + kstep, c00, c01); PG8_STAGE2(PG8_SB(1, 1), cB + hstepB + kstep, vB0, vB1);
    PG8_WAIT_V(6); PG8_BAR;
    for (;;) {
        const bool has_next = S.next(ui + 1, nxt);
        const char* nA = has_next ? S.a_base(nxt) : cA; const char* nB = has_next ? S.b_base(nxt) : cB;
        unsigned n00 = c00, n01 = c01, n10 = c10, n11 = c11;
        if (has_next) { n00 = S.a_off(nxt, R0, C0); n01 = S.a_off(nxt, R1, C1); n10 = S.a_off(nxt, HALF + R0, C0); n11 = S.a_off(nxt, HALF + R1, C1); }
        for (int t = 0; t < nt; t += 2) {
            const bool last = (t == nt - 2);
            const char* a1 = cA + (size_t)(t + 1) * kstep;
            const char* a2 = last ? nA : cA + (size_t)(t + 2) * kstep; const char* b2 = last ? nB : cB + (size_t)(t + 2) * kstep;
            const char* a3 = a2 + kstep; const char* b3 = b2 + kstep;
            const unsigned s00 = last ? n00 : c00, s01 = last ? n01 : c01, s10 = last ? n10 : c10, s11 = last ? n11 : c11;
            PG8_LDB(B0, 0, 0); PG8_LDB(B1, 0, 1); PG8_SCHED; PG8_LDA(At, 0, 0); PG8_STAGE2(PG8_SA(1, 1), a1, c10, c11);
            PG8_WAIT_V(8); PG8_WAIT_L(0); PG8_BAR; PG8_MMA(0, 0, At, B0); PG8_MMA(0, 1, At, B1); PG8_BAR; PG8_SCHED;
            PG8_LDA(At, 0, 1); PG8_STAGE2(PG8_SB(0, 0), b2, vB0, vB1); PG8_STAGE2(PG8_SB(0, 1), b2 + hstepB, vB0, vB1); PG8_STAGE2(PG8_SA(0, 0), a2, s00, s01);
            PG8_WAIT_V(8); PG8_WAIT_L(0); PG8_BAR; PG8_MMA(1, 0, At, B0); PG8_MMA(1, 1, At, B1); PG8_BAR; PG8_SCHED;
            PG8_LDB(B0, 1, 0); PG8_LDB(B1, 1, 1); PG8_SCHED; PG8_LDA(At, 1, 0); PG8_STAGE2(PG8_SA(0, 1), a2, s10, s11);
            PG8_WAIT_V(8); PG8_WAIT_L(0); PG8_BAR; PG8_MMA(0, 0, At, B0); PG8_MMA(0, 1, At, B1); PG8_BAR; PG8_SCHED;
            PG8_LDA(At, 1, 1); PG8_STAGE2(PG8_SB(1, 0), b3, vB0, vB1); PG8_STAGE2(PG8_SB(1, 1), b3 + hstepB, vB0, vB1); PG8_STAGE2(PG8_SA(1, 0), a3, s00, s01);
            PG8_WAIT_V(8); PG8_WAIT_L(0); PG8_BAR; PG8_MMA(1, 0, At, B0); PG8_MMA(1, 1, At, B1); PG8_BAR; PG8_SCHED;
        }
        if constexpr (ALIGN_EPI) { if (wr == 0) PG8_BAR; }
        E(acc, cur, wr, wc, fr, fq);
        if (!has_next) break;
        if (!(Epi::ACCUM && cur.sub + 1 < S.nsub)) {
#pragma unroll
        for (int a = 0; a < 2; ++a)
#pragma unroll
            for (int b = 0; b < 2; ++b)
#pragma unroll
                for (int m = 0; m < 4; ++m)
#pragma unroll
                    for (int n = 0; n < 2; ++n) acc[a][b][m][n] = (f32x4){0.f, 0.f, 0.f, 0.f};
        }
        cur = nxt; cA = nA; cB = nB; c00 = n00; c01 = n01; c10 = n10; c11 = n11; ++ui;
        if constexpr (ALIGN_EPI) { if (wr == 1) PG8_BAR; }
    }
    PG8_WAIT_V(0);
    if constexpr (!ALIGN_EPI) { if (wr == 0) PG8_BAR; }
    PG8_BAR;
#undef PG8_SA
#undef PG8_SB
#undef PG8_STAGE2
#undef PG8_LDA
#undef PG8_LDB
#undef PG8_MMA
#undef PG8_WAIT_V
#undef PG8_WAIT_L
#undef PG8_BAR
#undef PG8_SCHED
}

struct DenseOrder {
    const char* A; const char* Bt; int lda, ldb, K; int nM, nN, nwg, G, c, nsub;
    __device__ void init(const void* A_, int lda_, const void* Bt_, int ldb_, int M, int N, int K_, int G_, int c_, int nsub_ = 1) { A = (const char*)A_; Bt = (const char*)Bt_; lda = lda_; ldb = ldb_; K = K_; nM = M / BM; nN = N / BM; nwg = nM * nN; G = G_; c = c_; nsub = nsub_; }
    __device__ bool next(int i, Unit& u) const {
        u.sub = i % nsub; i /= nsub;
        const long L = (long)i * G + c; if (L >= nwg) return false;
        int wgid = (int)L; { const int q = nwg / 8, r = nwg % 8, xcd = wgid % 8, off = wgid / 8; wgid = (xcd < r ? xcd * (q + 1) : r * (q + 1) + (xcd - r) * q) + off; }
        const int nig = 8 * nN, gid = wgid / nig, fm = gid * 8, gsz = (nM - fm) < 8 ? (nM - fm) : 8;
        u.pm = fm + ((wgid % nig) % gsz); u.pn = (wgid % nig) / gsz; u.e = 0; u.p0 = 0; u.nvalid = 256; u.prow = 0; return true;
    }
    __device__ __forceinline__ const char* a_base(const Unit& u) const { return A + (size_t)u.pm * BM * lda * 2 + (size_t)u.sub * K * 2; }
    __device__ __forceinline__ const char* b_base(const Unit& u) const { return Bt + (size_t)u.pn * BM * ldb * 2 + (size_t)u.sub * K * 2; }
    __device__ __forceinline__ unsigned a_off(const Unit&, int row, int col) const { return (unsigned)(row * lda + col) * 2u; }
};
struct GroupOrder {
    static constexpr int nsub = 1;
    const char* A; const char* Bt; size_t strideA, strideB; int lda, ldb, K; int nM, nN, nwg, G, c;
    __device__ void init(const void* A_, size_t sA, int lda_, const void* Bt_, size_t sB, int ldb_, int ngroups, int M, int N, int K_, int G_, int c_) {
        A = (const char*)A_; Bt = (const char*)Bt_; strideA = sA; strideB = sB; lda = lda_; ldb = ldb_; K = K_; nM = M / BM; nN = N / BM; nwg = ngroups * nM * nN; G = G_; c = c_; }
    __device__ bool next(int i, Unit& u) const {
        const long L = (long)i * G + c; if (L >= nwg) return false;
        const int per = nM * nN; u.e = (int)L / per; const int r = (int)L % per; u.pm = r / nN; u.pn = r % nN; u.p0 = 0; u.nvalid = 256; u.prow = 0; u.sub = 0; return true;
    }
    __device__ __forceinline__ const char* a_base(const Unit& u) const { return A + (size_t)u.e * strideA + (size_t)u.pm * BM * lda * 2; }
    __device__ __forceinline__ const char* b_base(const Unit& u) const { return Bt + (size_t)u.e * strideB + (size_t)u.pn * BM * ldb * 2; }
    __device__ __forceinline__ unsigned a_off(const Unit&, int row, int col) const { return (unsigned)(row * lda + col) * 2u; }
};
template <bool GATHER>
struct MoeOrder {
    static constexpr int nsub = 1;
    const char* A; const char* Bt; size_t strideB; int lda, ldb, K; int nN, G, c; const unsigned* cnt; const int* list;
    __device__ bool next(int i, Unit& u) const {
        const int uu = i * G + c; const int q = uu / nN; u.pn = uu % nN; int accp = 0; bool found = false;
        for (int e = 0; e < NE; ++e) { const int n = (int)ld_agent(cnt + e); const int np = (n + 255) >> 8;
            if (!found && q < accp + np) { u.e = e; u.p0 = (q - accp) * 256; u.nvalid = (n - u.p0) < 256 ? (n - u.p0) : 256; found = true; }
            accp += np; }
        u.pm = q; u.prow = q * 256; u.sub = 0; return found;
    }
    __device__ __forceinline__ const char* a_base(const Unit& u) const { return GATHER ? A : A + (size_t)u.prow * lda * 2; }
    __device__ __forceinline__ const char* b_base(const Unit& u) const { return Bt + (size_t)u.e * strideB + (size_t)u.pn * BM * ldb * 2; }
    __device__ __forceinline__ unsigned a_off(const Unit& u, int row, int col) const {
        if (GATHER) { int tok = 0; if (row < u.nvalid) tok = (int)ld_agent((const unsigned*)list + (size_t)u.e * CAP + u.p0 + row) >> 1; return (unsigned)(tok * lda + col) * 2u; }
        return (unsigned)(row * lda + col) * 2u;
    }
};
}

using pg8::Unit;
#define EPI_LOOP_AI_M _Pragma("unroll") for (int ai = 0; ai < 2; ++ai) _Pragma("unroll") for (int m = 0; m < 4; ++m)
__device__ __forceinline__ u32x4 pack8(const f32x4& a, const f32x4& b) { u32x4 w; w.x = cvt_pk_bf16(a[0], a[1]); w.y = cvt_pk_bf16(a[2], a[3]); w.z = cvt_pk_bf16(b[0], b[1]); w.w = cvt_pk_bf16(b[2], b[3]); return w; }
__device__ __forceinline__ void unpack8(const u32x4& w, f32x4& a, f32x4& b) { a = (f32x4){bflo(w.x), bfhi(w.x), bflo(w.y), bfhi(w.y)}; b = (f32x4){bflo(w.z), bfhi(w.z), bflo(w.w), bfhi(w.w)}; }

struct EpiInProj {
    static constexpr bool PERM = true, ACCUM = false;
    bf16_t* PA; bf16_t* UV; bf16_t* UG; bf16_t* GATES; const float* bgate;
    __device__ __forceinline__ void operator()(f32x4 (&acc)[2][2][4][2], const Unit& u, int wr, int wc, int fr, int fq) const {
        const int row0 = u.pm * 256 + wr * 64 + fr, colt = u.pn * 256 + wc * 32 + 8 * fq;
        EPI_LOOP_AI_M { const int r = row0 + ai * 128 + m * 16;
#pragma unroll
            for (int bj = 0; bj < 2; ++bj) { const int c = colt + bj * 128; f32x4 v0 = acc[ai][bj][m][0], v1 = acc[ai][bj][m][1]; bf16_t* dst;
                if (u.pn < 2) dst = PA + (size_t)r * 512 + c;
                else if (u.pn < 6) { dst = UV + (size_t)r * 1024 + (c - 512);
#pragma unroll
                    for (int j = 0; j < 4; ++j) { v0[j] = gelu_tanh_fast(v0[j]); v1[j] = gelu_tanh_fast(v1[j]); } }
                else if (u.pn < 8) { const int cs = c - 1536, g = cs >> 4, cc = cs & 15, n = r >> 5, s = r & 31; dst = UG + ((size_t)(g * NCH + n) * UGLD + s * 16 + cc); }
                else { const int cg = c - 2048; dst = GATES + (size_t)r * 3072 + cg; const f32x4 b0 = *(const f32x4*)(bgate + cg), b1 = *(const f32x4*)(bgate + cg + 4);
#pragma unroll
                    for (int j = 0; j < 4; ++j) { v0[j] = fast_sigmoid(v0[j] + b0[j]); v1[j] = fast_sigmoid(v1[j] + b1[j]); } }
                *(u32x4*)dst = pack8(v0, v1); } }
    }
};
struct EpiSst {
    static constexpr bool PERM = false, ACCUM = false;
    float* SST;
    __device__ __forceinline__ void operator()(f32x4 (&acc)[2][2][4][2], const Unit& u, int wr, int wc, int fr, int fq) const {
        const int row0 = u.pm * 256 + wr * 64 + fr, col0 = wc * 32 + 4 * fq;
        EPI_LOOP_AI_M { float* rowp = SST + ((size_t)u.e * NCH + row0 + ai * 128 + m * 16) * 128 + col0;
#pragma unroll
            for (int n = 0; n < 2; ++n) *(f32x4*)(rowp + n * 16) = acc[ai][0][m][n]; }
    }
};
struct EpiSsmOut {
    static constexpr bool PERM = true, ACCUM = false;
    bf16_t* YG;
    __device__ __forceinline__ void operator()(f32x4 (&acc)[2][2][4][2], const Unit& u, int wr, int wc, int fr, int fq) const {
        const int row0 = u.pm * 256 + wr * 64 + fr, colt = u.pn * 256 + wc * 32 + 8 * fq;
        EPI_LOOP_AI_M { const int n = row0 + ai * 128 + m * 16;
#pragma unroll
            for (int bj = 0; bj < 2; ++bj) { const int c = colt + bj * 128, t = c >> 4, cc = c & 15; f32x4 v0 = acc[ai][bj][m][0], v1 = acc[ai][bj][m][1];
#pragma unroll
                for (int j = 0; j < 4; ++j) { v0[j] = gelu_tanh_fast(v0[j]); v1[j] = gelu_tanh_fast(v1[j]); }
                *(u32x4*)(YG + (size_t)(n * QC + t) * 512 + u.e * 16 + cc) = pack8(v0, v1); } }
    }
};
struct EpiGlu {
    static constexpr bool PERM = true, ACCUM = false;
    const bf16_t* YG; bf16_t* YS; const float* gb;
    __device__ __forceinline__ void operator()(f32x4 (&acc)[2][2][4][2], const Unit& u, int wr, int wc, int fr, int fq) const {
        const int row0 = u.pm * 256 + wr * 64 + fr, colt = u.pn * 256 + wc * 32 + 8 * fq;
        EPI_LOOP_AI_M { const int r = row0 + ai * 128 + m * 16;
#pragma unroll
            for (int bj = 0; bj < 2; ++bj) { const int c = colt + bj * 128; f32x4 v0 = acc[ai][bj][m][0], v1 = acc[ai][bj][m][1], y0, y1;
                const f32x4 b0 = *(const f32x4*)(gb + c), b1 = *(const f32x4*)(gb + c + 4);
                unpack8(*(const u32x4*)(YG + (size_t)r * 512 + c), y0, y1);
#pragma unroll
                for (int j = 0; j < 4; ++j) { v0[j] = y0[j] * fast_sigmoid(v0[j] + b0[j]); v1[j] = y1[j] * fast_sigmoid(v1[j] + b1[j]); }
                *(u32x4*)(YS + (size_t)r * 1536 + 1024 + c) = pack8(v0, v1); }
            asm volatile("" ::: "memory"); }
    }
};
struct EpiBranch {
    static constexpr bool PERM = true, ACCUM = true;
    const bf16_t* GATES; bf16_t* MERGED;
    __device__ __forceinline__ void operator()(f32x4 (&acc)[2][2][4][2], const Unit& u, int wr, int wc, int fr, int fq) const {
        const int row0 = u.pm * 256 + wr * 64 + fr, colt = u.pn * 256 + wc * 32 + 8 * fq;
        if (u.sub < 2) {
            EPI_LOOP_AI_M { const int r = row0 + ai * 128 + m * 16;
#pragma unroll
                for (int bj = 0; bj < 2; ++bj) { const int c = colt + bj * 128; f32x4 a0, a1, b0, b1;
                    unpack8(*(const u32x4*)(GATES + (size_t)r * 3072 + u.sub * 1024 + c), a0, a1); unpack8(*(const u32x4*)(GATES + (size_t)r * 3072 + (u.sub + 1) * 1024 + c), b0, b1);
#pragma unroll
                    for (int j = 0; j < 4; ++j) { acc[ai][bj][m][0][j] *= a0[j] * __builtin_amdgcn_rcpf(b0[j]); acc[ai][bj][m][1][j] *= a1[j] * __builtin_amdgcn_rcpf(b1[j]); } }
                asm volatile("" ::: "memory"); }
        } else {
            EPI_LOOP_AI_M { const int r = row0 + ai * 128 + m * 16;
#pragma unroll
                for (int bj = 0; bj < 2; ++bj) { const int c = colt + bj * 128; f32x4 g0, g1;
                    unpack8(*(const u32x4*)(GATES + (size_t)r * 3072 + 2048 + c), g0, g1);
                    *(u32x4*)(MERGED + (size_t)r * 1024 + c) = pack8(acc[ai][bj][m][0] * g0, acc[ai][bj][m][1] * g1); }
                asm volatile("" ::: "memory"); }
        }
    }
};
struct EpiWout {
    static constexpr bool PERM = false, ACCUM = false;
    float* X;
    __device__ __forceinline__ void operator()(f32x4 (&acc)[2][2][4][2], const Unit& u, int wr, int wc, int fr, int fq) const {
        const int row0 = u.pm * 256 + wr * 64 + fr, col0 = u.pn * 256 + wc * 32 + 4 * fq;
        EPI_LOOP_AI_M { float* rowp = X + (size_t)(row0 + ai * 128 + m * 16) * 1024 + col0;
#pragma unroll
            for (int bj = 0; bj < 2; ++bj)
#pragma unroll
                for (int n = 0; n < 2; ++n) { f32x4* q = (f32x4*)(rowp + bj * 128 + n * 16); *q = *q + acc[ai][bj][m][n]; }
            asm volatile("" ::: "memory"); }
    }
};
struct EpiMoe1 {
    static constexpr bool PERM = true, ACCUM = false;
    bf16_t* ACT; const float* LW;
    __device__ __forceinline__ void operator()(f32x4 (&acc)[2][2][4][2], const Unit& u, int wr, int wc, int fr, int fq) const {
        const int rl0 = wr * 64 + fr, j0 = wc * 32 + 8 * fq;
        EPI_LOOP_AI_M { const int rl = rl0 + ai * 128 + m * 16; float w = 0.f;
            if (rl < u.nvalid) w = __uint_as_float(ld_agent((const unsigned*)LW + (size_t)u.e * CAP + u.p0 + rl));
            f32x4 g0 = acc[ai][0][m][0], g1 = acc[ai][0][m][1]; const f32x4 u0 = acc[ai][1][m][0], u1 = acc[ai][1][m][1];
#pragma unroll
            for (int j = 0; j < 4; ++j) { g0[j] = w * g0[j] * fast_sigmoid(g0[j]) * u0[j]; g1[j] = w * g1[j] * fast_sigmoid(g1[j]) * u1[j]; }
            *(u32x4*)(ACT + (size_t)(u.prow + rl) * 512 + u.pn * 128 + j0) = pack8(g0, g1); }
    }
};
struct EpiMoe2 {
    static constexpr bool PERM = true, ACCUM = false;
    bf16_t* YB; const int* LIST;
    __device__ __forceinline__ void operator()(f32x4 (&acc)[2][2][4][2], const Unit& u, int wr, int wc, int fr, int fq) const {
        const int rl0 = wr * 64 + fr, colt = u.pn * 256 + wc * 32 + 8 * fq;
        EPI_LOOP_AI_M { const int rl = rl0 + ai * 128 + m * 16;
            if (rl < u.nvalid) { const int idx = (int)ld_agent((const unsigned*)LIST + (size_t)u.e * CAP + u.p0 + rl); const int tok = idx >> 1, slot = idx & 1;
                bf16_t* rowp = YB + ((size_t)slot * T + tok) * 1024 + colt;
#pragma unroll
                for (int bj = 0; bj < 2; ++bj) *(u32x4*)(rowp + bj * 128) = pack8(acc[ai][bj][m][0], acc[ai][bj][m][1]); } }
    }
};

__device__ __forceinline__ void conv_tile(const float* src, int ldsrc, int k0, int n0, bf16_t* dst, int ldd, int drow0, int dcol0, LAS float* tile) {
    const int tid = threadIdx.x; const int r = tid >> 4, c4 = (tid & 15) * 4;
#pragma unroll
    for (int h = 0; h < 2; ++h) { const int rr = r + 32 * h; const f32x4 v = *(const f32x4*)(src + (size_t)(k0 + rr) * ldsrc + n0 + c4);
        tile[rr * 65 + c4 + 0] = v[0]; tile[rr * 65 + c4 + 1] = v[1]; tile[rr * 65 + c4 + 2] = v[2]; tile[rr * 65 + c4 + 3] = v[3]; }
    __syncthreads();
    const int j = tid >> 3, kc = (tid & 7) * 8; float v[8];
#pragma unroll
    for (int i = 0; i < 8; ++i) v[i] = tile[(kc + i) * 65 + j];
    u32x4 w; w.x = cvt_pk_bf16(v[0], v[1]); w.y = cvt_pk_bf16(v[2], v[3]); w.z = cvt_pk_bf16(v[4], v[5]); w.w = cvt_pk_bf16(v[6], v[7]);
    *(u32x4*)(dst + (size_t)(drow0 + j) * ldd + dcol0 + k0 + kc) = w;
    __syncthreads();
}
constexpr int CV_WIN = 1280, CV_WB = 256, CV_WOUT = 256, CV_GLU = 64, CV_GU = 8192, CV_DN = 4096;
constexpr int CV_TILES = CV_WIN + CV_WB + CV_WOUT + CV_GLU + CV_GU + CV_DN;
constexpr int CV_WEFF = 1024;
constexpr int CV_SGW = 128;
constexpr int CV_SSM = 128;
constexpr int CV_UNITS = CV_TILES + CV_WEFF + CV_SGW + CV_SSM;

__device__ __forceinline__ void ssm_precompute(const Params& p, const LayerPtrs& L, int g, int q, LAS unsigned char* lds);

__device__ __forceinline__ void st_conv(const Params& p, int l, int bid, int nb, LAS unsigned char* lds) {
    const LayerPtrs L = layer_ptrs(p, l);
    LAS float* tile = (LAS float*)lds;
    bf16_t* WIN = WSP(bf16_t, WS_WIN); bf16_t* WB = WSP(bf16_t, WS_WB); bf16_t* WOUT = WSP(bf16_t, WS_WOUT); bf16_t* GLU = WSP(bf16_t, WS_GLU);
    bf16_t* WGU = WSP(bf16_t, WS_WGU); bf16_t* WD = WSP(bf16_t, WS_WD); bf16_t* SGW = WSP(bf16_t, WS_SGW);
    for (int u = bid; u < CV_UNITS; u += nb) {
        int i = u;
        if (i < CV_WIN) { conv_tile(L.w_in, INC, (i & 15) * 64, (i >> 4) * 64, WIN, 1024, (i >> 4) * 64, 0, tile); continue; }
        i -= CV_WIN;
        if (i < CV_WB) { const int k = 1 + (i >> 7), s = i & 127; conv_tile(L.w_branch + (size_t)k * 512 * 1024, 1024, (s & 7) * 64, (s >> 3) * 64, WB, 1536, (s >> 3) * 64, k * 512, tile); continue; }
        i -= CV_WB;
        if (i < CV_WOUT) { conv_tile(L.w_out, 1024, (i & 15) * 64, (i >> 4) * 64, WOUT, 1024, (i >> 4) * 64, 0, tile); continue; }
        i -= CV_WOUT;
        if (i < CV_GLU) { conv_tile(L.glu_w, 512, (i & 7) * 64, (i >> 3) * 64, GLU, 512, (i >> 3) * 64, 0, tile); continue; }
        i -= CV_GLU;
        if (i < CV_GU) { const int e = i >> 8, s = i & 255, isup = s >> 7, ss = s & 127, tk = ss & 15, tn = ss >> 4; const int n0 = tn * 64;
            const float* src = (isup ? L.wu : L.wg) + (size_t)e * 1024 * 512;
            conv_tile(src, 512, tk * 64, n0, WGU + (size_t)e * 1024 * 1024, 1024, 256 * (n0 >> 7) + (n0 & 127) + (isup ? 128 : 0), 0, tile); continue; }
        i -= CV_GU;
        if (i < CV_DN) { const int e = i >> 7, s = i & 127, tk = s & 7, tn = s >> 3; conv_tile(L.wd + (size_t)e * 512 * 1024, 1024, tk * 64, tn * 64, WD + (size_t)e * 1024 * 512, 512, tn * 64, 0, tile); continue; }
        i -= CV_DN;
        if (i < CV_WEFF) {
            const int o = i * 512 + threadIdx.x; const int kk = o >> 10, n = o & 1023, g = kk >> 7, c = kk & 127; float s = 0.f;
            const float* pw = L.pool_w + ((size_t)g * 128 + c) * 128; const float* sc = L.pool_scale + g * 128; const float* wb = L.w_branch + (size_t)(g * 128) * 1024 + n;
            for (int d = 0; d < 128; ++d) s += pw[d] * sc[d] * wb[(size_t)d * 1024];
            WB[(size_t)n * 1536 + kk] = f2bf(s); continue; }
        i -= CV_WEFF;
        if (i < CV_SGW) { const int o = i * 512 + threadIdx.x; const int s = o & 127, t = (o >> 7) & 127; SGW[o] = (s <= t) ? f2bf(L.sgu_w[o]) : (bf16_t)0; continue; }
        i -= CV_SGW;
        ssm_precompute(p, L, i >> 2, i & 3, lds);
    }
}

__device__ __forceinline__ void ssm_precompute(const Params& p, const LayerPtrs& L, int g, int q, LAS unsigned char* lds) {
    LAS f32x2* LP = (LAS f32x2*)lds; LAS f32x2* BB = (LAS f32x2*)(lds + 16896); LAS f32x2* CC = (LAS f32x2*)(lds + 16896 + 8192); LAS float* KM = (LAS float*)(lds + 16896 + 16384);
    bf16_t* ET = WSP(bf16_t, WS_ET) + (size_t)g * 256 * 512; bf16_t* TZF = WSP(bf16_t, WS_TZF) + (size_t)g * 512 * UGLD;
    const int tid = threadIdx.x; const float dt = expf(L.log_dt[g]);
    for (int o = tid; o < 33 * 64; o += NTHREADS) { const int j = o >> 6, pp = o & 63; const float lre = L.a_re[g * 64 + pp], lim = L.a_im[g * 64 + pp];
        const float er = expf((float)j * lre * dt); LP[o] = (f32x2){er * cosf((float)j * lim * dt), er * sinf((float)j * lim * dt)}; }
    for (int o = tid; o < 64 * 16; o += NTHREADS) { const int pp = o >> 4; const float lre = L.a_re[g * 64 + pp], lim = L.a_im[g * 64 + pp];
        const float er = expf(lre * dt), lbr = er * cosf(lim * dt), lbi = er * sinf(lim * dt); const float nr = lbr - 1.f, ni = lbi, den = lre * lre + lim * lim;
        const float cr = (nr * lre + ni * lim) / den, ci = (ni * lre - nr * lim) / den; const float br = L.b_re[(size_t)g * 1024 + o], bi = L.b_im[(size_t)g * 1024 + o];
        BB[o] = (f32x2){cr * br - ci * bi, cr * bi + ci * br}; }
    for (int o = tid; o < 16 * 64; o += NTHREADS) CC[o] = (f32x2){L.c_re[(size_t)g * 1024 + o], L.c_im[(size_t)g * 1024 + o]};
    __syncthreads();
    const int nj = 8 * q + 8;
    for (int o = tid; o < nj * 256; o += NTHREADS) { const int j = o >> 8, c = (o >> 4) & 15, c2 = o & 15; float s = 0.f;
        for (int pp = 0; pp < 64; ++pp) { const f32x2 cv = CC[c * 64 + pp], lp = LP[j * 64 + pp], bb = BB[pp * 16 + c2];
            const float mr = cv.x * lp.x - cv.y * lp.y, mi = cv.x * lp.y + cv.y * lp.x; s += mr * bb.x - mi * bb.y; }
        if (j == 0 && c == c2) s += L.ssm_d[g * 16 + c];
        KM[o] = s; }
    __syncthreads();
    for (int o = tid; o < 64 * 64; o += NTHREADS) { const int rr = 64 * q + (o >> 6), k8 = (o & 63) * 8; float v[8];
#pragma unroll
        for (int i = 0; i < 8; ++i) { float x = 0.f; if (rr < 128) { const int pp = rr >> 1, ri = rr & 1, k = k8 + i, s = k >> 4, c2 = k & 15; const f32x2 lp = LP[(31 - s) * 64 + pp], bb = BB[pp * 16 + c2];
                x = ri ? (lp.x * bb.y + lp.y * bb.x) : (lp.x * bb.x - lp.y * bb.y); } v[i] = x; }
        u32x4 w; w.x = cvt_pk_bf16(v[0], v[1]); w.y = cvt_pk_bf16(v[2], v[3]); w.z = cvt_pk_bf16(v[4], v[5]); w.w = cvt_pk_bf16(v[6], v[7]);
        *(u32x4*)(ET + (size_t)rr * 512 + k8) = w; }
    for (int o = tid; o < 128 * 80; o += NTHREADS) { const int row = 128 * q + o / 80, k8 = (o % 80) * 8, t = row >> 4, c = row & 15; float v[8];
#pragma unroll
        for (int i = 0; i < 8; ++i) { const int k = k8 + i; float x;
            if (k < 512) { const int s = k >> 4, c2 = k & 15; x = (s <= t) ? KM[(t - s) * 256 + c * 16 + c2] : 0.f; }
            else { const int kk = k - 512, pp = kk >> 1, ri = kk & 1; const f32x2 cv = CC[c * 64 + pp], lp = LP[(t + 1) * 64 + pp];
                x = ri ? -(cv.x * lp.y + cv.y * lp.x) : (cv.x * lp.x - cv.y * lp.y); }
            v[i] = x; }
        u32x4 w; w.x = cvt_pk_bf16(v[0], v[1]); w.y = cvt_pk_bf16(v[2], v[3]); w.z = cvt_pk_bf16(v[4], v[5]); w.w = cvt_pk_bf16(v[6], v[7]);
        *(u32x4*)(TZF + (size_t)row * UGLD + k8) = w; }
    __syncthreads();
}

template <bool ADD_YB, bool FINAL>
__device__ __forceinline__ void st_prep(const Params& p, const float* gain, int bid, int nb) {
    float* X = p.out; bf16_t* HB = WSP(bf16_t, WS_HB); const bf16_t* YB = WSP(bf16_t, WS_YB);
    const int wave = threadIdx.x >> 6, lane = threadIdx.x & 63;
    for (int t = bid * 8 + wave; t < T; t += nb * 8) {
        f32x4 v[4]; float ss = 0.f;
#pragma unroll
        for (int i = 0; i < 4; ++i) { const int c = 4 * (lane + 64 * i); v[i] = *(const f32x4*)(X + (size_t)t * D + c);
            if (ADD_YB) { const u32x2 a = *(const u32x2*)(YB + (size_t)t * D + c), b = *(const u32x2*)(YB + ((size_t)T + t) * D + c);
                v[i][0] += bflo(a.x) + bflo(b.x); v[i][1] += bfhi(a.x) + bfhi(b.x); v[i][2] += bflo(a.y) + bflo(b.y); v[i][3] += bfhi(a.y) + bfhi(b.y); }
            ss += v[i][0] * v[i][0] + v[i][1] * v[i][1] + v[i][2] * v[i][2] + v[i][3] * v[i][3]; }
        ss = wave_sum(ss); const float r = rsqrtf(ss / (float)D + EPS);
#pragma unroll
        for (int i = 0; i < 4; ++i) { const int c = 4 * (lane + 64 * i); const f32x4 g = *(const f32x4*)(gain + c); const f32x4 h = v[i] * r * g;
            if (FINAL) *(f32x4*)(X + (size_t)t * D + c) = h;
            else { if (ADD_YB) *(f32x4*)(X + (size_t)t * D + c) = v[i]; u32x2 w; w.x = cvt_pk_bf16(h[0], h[1]); w.y = cvt_pk_bf16(h[2], h[3]); *(u32x2*)(HB + (size_t)t * D + c) = w; } }
    }
}

__device__ __forceinline__ void st_pool(const Params& p, int bid, int nb) {
    const bf16_t* PA = WSP(bf16_t, WS_PA); bf16_t* YS = WSP(bf16_t, WS_YS);
    for (int idx = bid * NTHREADS + threadIdx.x; idx < T * 64; idx += nb * NTHREADS) {
        const int t = idx >> 6, ch = (idx & 63) * 8, g = ch >> 7, w = 2 << g, pos = t & (SEQ - 1), cnt = (pos + 1 < w) ? pos + 1 : w;
        f32x4 s0 = {0.f, 0.f, 0.f, 0.f}, s1 = s0, x0, x1;
        unpack8(*(const u32x4*)(PA + (size_t)t * 512 + ch), x0, x1); s0 = x0; s1 = x1;
        for (int j = 1; j < cnt; ++j) { f32x4 a0, a1; unpack8(*(const u32x4*)(PA + (size_t)(t - j) * 512 + ch), a0, a1); s0 = s0 + a0; s1 = s1 + a1; }
        const float inv = 1.0f / (float)cnt;
        *(u32x4*)(YS + (size_t)t * 1536 + ch) = pack8(s0 * inv - x0, s1 * inv - x1);
    }
}

__device__ __forceinline__ void sgu_unit(const Params& p, const LayerPtrs& L, int unit, LAS unsigned char* lds) {
    const bf16_t* UV = WSP(bf16_t, WS_UV); bf16_t* YS = WSP(bf16_t, WS_YS); const bf16_t* SGW = WSP(bf16_t, WS_SGW);
    LAS bf16_t* VT = (LAS bf16_t*)lds; LAS float* MU = (LAS float*)(lds + 34816); LAS float* RS = MU + 128;
    const int cb = (unit >> 2) * 128, h = unit & 3; const int tid = threadIdx.x, wave = tid >> 6, lane = tid & 63;
    for (int i = 0; i < 16; ++i) { const int s = wave * 16 + i; f32x4 a0, a1; unpack8(*(const u32x4*)(UV + (size_t)(cb + s) * 1024 + 512 + lane * 8), a0, a1);
        float sm = (a0[0] + a0[1]) + (a0[2] + a0[3]) + (a1[0] + a1[1]) + (a1[2] + a1[3]); sm = wave_sum(sm); const float mu = sm * (1.0f / 512.0f);
        const f32x4 d0 = a0 - mu, d1 = a1 - mu; float q = d0[0] * d0[0] + d0[1] * d0[1] + d0[2] * d0[2] + d0[3] * d0[3] + d1[0] * d1[0] + d1[1] * d1[1] + d1[2] * d1[2] + d1[3] * d1[3];
        q = wave_sum(q); if (lane == 0) { MU[s] = mu; RS[s] = rsqrtf(q * (1.0f / 512.0f) + EPS); } }
    __syncthreads();
    { const int s = tid & 127, cq = tid >> 7; const float mu = MU[s], rs = RS[s];
#pragma unroll
        for (int i = 0; i < 4; ++i) { const int c8 = (cq * 4 + i) * 8; f32x4 a0, a1; unpack8(*(const u32x4*)(UV + (size_t)(cb + s) * 1024 + 512 + h * 128 + c8), a0, a1);
            const f32x4 g0 = *(const f32x4*)(L.ln_g + h * 128 + c8), g1 = *(const f32x4*)(L.ln_g + h * 128 + c8 + 4), b0 = *(const f32x4*)(L.ln_b + h * 128 + c8), b1 = *(const f32x4*)(L.ln_b + h * 128 + c8 + 4);
            a0 = (a0 - mu) * rs * g0 + b0; a1 = (a1 - mu) * rs * g1 + b1;
#pragma unroll
            for (int j = 0; j < 4; ++j) { VT[(c8 + j) * 136 + s] = f2bf(a0[j]); VT[(c8 + 4 + j) * 136 + s] = f2bf(a1[j]); } } }
    __syncthreads();
    const int fr = lane & 15, fq = lane >> 4;
    bf16x8 A[4];
#pragma unroll
    for (int ks = 0; ks < 4; ++ks) A[ks] = *(const bf16x8*)(SGW + ((size_t)h * 128 + wave * 16 + fr) * 128 + ks * 32 + fq * 8);
    f32x4 acc[8];
#pragma unroll
    for (int n = 0; n < 8; ++n) { acc[n] = (f32x4){0.f, 0.f, 0.f, 0.f};
#pragma unroll
        for (int ks = 0; ks < 4; ++ks) { const bf16x8 B = *(const LAS bf16x8*)(VT + (n * 16 + fr) * 136 + ks * 32 + fq * 8); acc[n] = __builtin_amdgcn_mfma_f32_16x16x32_bf16(A[ks], B, acc[n], 0, 0, 0); } }
#pragma unroll
    for (int n = 0; n < 8; ++n)
#pragma unroll
        for (int r = 0; r < 4; ++r) { const int tl = wave * 16 + 4 * fq + r, ch = h * 128 + n * 16 + fr; const float sv = acc[n][r] + L.sgu_b[h * 128 + tl];
            const float uu = bf2f(UV[(size_t)(cb + tl) * 1024 + ch]); YS[(size_t)(cb + tl) * 1536 + 512 + ch] = f2bf(uu * sv); }
    __syncthreads();
}

__device__ __forceinline__ void st_scan(const Params& p, const LayerPtrs& L, int bid, int nb) {
    const float* SST = WSP(float, WS_SST); bf16_t* UG = WSP(bf16_t, WS_UG);
    const int wave = threadIdx.x >> 6, lane = threadIdx.x & 63; const int w = bid * 8 + wave;
    if (w >= 128) return;
    const int b = w >> 5, g = w & 31; const float dt = expf(L.log_dt[g]); const float lre = L.a_re[g * 64 + lane], lim = L.a_im[g * 64 + lane];
    const float er = expf((float)QC * lre * dt); const float qr = er * cosf((float)QC * lim * dt), qi = er * sinf((float)QC * lim * dt);
    float xr = 0.f, xi = 0.f;
    for (int k = 0; k < SEQ / QC; ++k) { const int n = b * (SEQ / QC) + k;
        *(unsigned*)(UG + ((size_t)g * NCH + n) * UGLD + 512 + 2 * lane) = cvt_pk_bf16(xr, xi);
        const f32x2 s = *(const f32x2*)(SST + ((size_t)g * NCH + n) * 128 + 2 * lane);
        const float nr = qr * xr - qi * xi + s.x, ni = qr * xi + qi * xr + s.y; xr = nr; xi = ni; }
}

__device__ __forceinline__ void st_route(const Params& p, const LayerPtrs& L, int l, int bid, int nb, LAS unsigned char* lds) {
    LAS float* RW = (LAS float*)lds; const float* X = p.out; bf16_t* HB = WSP(bf16_t, WS_HB);
    unsigned* cnt = WSP(unsigned, WS_CTL) + CW_CNT + l * 32; int* LIST = WSP(int, WS_LIST); float* LW = WSP(float, WS_LW);
    const int tid = threadIdx.x, wave = tid >> 6, lane = tid & 63;
    for (int o = tid; o < 36 * 1024; o += NTHREADS) { const int k = o / 36, j = o % 36; RW[j * 1024 + k] = (j < 4) ? L.rgw[k * 4 + j] : L.rew[k * 32 + (j - 4)]; }
    __syncthreads();
    for (int t = bid * 8 + wave; t < T; t += nb * 8) {
        f32x4 v[4]; float ss = 0.f;
#pragma unroll
        for (int i = 0; i < 4; ++i) { const int c = 4 * (lane + 64 * i); v[i] = *(const f32x4*)(X + (size_t)t * D + c); ss += v[i][0] * v[i][0] + v[i][1] * v[i][1] + v[i][2] * v[i][2] + v[i][3] * v[i][3]; }
        ss = wave_sum(ss); const float r = rsqrtf(ss / (float)D + EPS);
#pragma unroll
        for (int i = 0; i < 4; ++i) { const int c = 4 * (lane + 64 * i); const f32x4 g = *(const f32x4*)(L.norm_ffn_g + c); v[i] = v[i] * r * g;
            u32x2 w; w.x = cvt_pk_bf16(v[i][0], v[i][1]); w.y = cvt_pk_bf16(v[i][2], v[i][3]); *(u32x2*)(HB + (size_t)t * D + c) = w; }
        float lg[36];
#pragma unroll
        for (int j = 0; j < 36; ++j) { float s = 0.f;
#pragma unroll
            for (int i = 0; i < 4; ++i) { const f32x4 w = *(const LAS f32x4*)(RW + j * 1024 + 4 * (lane + 64 * i)); s += v[i][0] * w[0] + v[i][1] * w[1] + v[i][2] * w[2] + v[i][3] * w[3]; }
            lg[j] = wave_sum(s); }
#pragma unroll
        for (int j = 0; j < 4; ++j) lg[j] += L.rgb[j];
#pragma unroll
        for (int j = 0; j < 32; ++j) lg[4 + j] += L.reb[j];
        int gi = 0; float gm = lg[0];
#pragma unroll
        for (int j = 1; j < 4; ++j) if (lg[j] > gm) { gm = lg[j]; gi = j; }
        float gs = 0.f;
#pragma unroll
        for (int j = 0; j < 4; ++j) gs += expf(lg[j] - gm);
        const float gval = 1.0f / gs;
        float el[8];
#pragma unroll
        for (int j = 0; j < 8; ++j) el[j] = gi == 0 ? lg[4 + j] : gi == 1 ? lg[12 + j] : gi == 2 ? lg[20 + j] : lg[28 + j];
        int i0 = 0; float v0 = el[0];
#pragma unroll
        for (int j = 1; j < 8; ++j) if (el[j] > v0) { v0 = el[j]; i0 = j; }
        int i1 = -1; float v1 = -INFINITY;
#pragma unroll
        for (int j = 0; j < 8; ++j) if (j != i0 && el[j] > v1) { v1 = el[j]; i1 = j; }
        const float e1 = expf(v1 - v0); const float w0 = gval / (1.f + e1), w1 = gval * e1 / (1.f + e1);
        if (lane < 2) { const int e = gi * 8 + (lane == 0 ? i0 : i1); const unsigned pos = atomicAdd(cnt + e, 1u);
            LIST[(size_t)e * CAP + pos] = t * 2 + lane; LW[(size_t)e * CAP + pos] = lane == 0 ? w0 : w1; }
    }
    __syncthreads();
}

namespace tw {
__device__ __forceinline__ float dot_bf16(const bf16_t* a, const bf16_t* b, int K) { float s = 0.f;
    for (int k = 0; k < K; k += 8) { f32x4 a0, a1, b0, b1; unpack8(*(const u32x4*)(a + k), a0, a1); unpack8(*(const u32x4*)(b + k), b0, b1);
        s += a0[0] * b0[0] + a0[1] * b0[1] + a0[2] * b0[2] + a0[3] * b0[3] + a1[0] * b1[0] + a1[1] * b1[1] + a1[2] * b1[2] + a1[3] * b1[3]; } return s; }
__global__ void __launch_bounds__(256) inproj(Params p, int l) {
    const LayerPtrs L = layer_ptrs(p, l); const int t = blockIdx.y, c = blockIdx.x * 256 + threadIdx.x;
    const float a = dot_bf16(WSP(bf16_t, WS_HB) + (size_t)t * 1024, WSP(bf16_t, WS_WIN) + (size_t)c * 1024, 1024);
    if (c < 512) WSP(bf16_t, WS_PA)[(size_t)t * 512 + c] = f2bf(a);
    else if (c < 1536) WSP(bf16_t, WS_UV)[(size_t)t * 1024 + c - 512] = f2bf(gelu_tanh_ref(a));
    else if (c < 2048) { const int cs = c - 1536, g = cs >> 4, cc = cs & 15, n = t >> 5, s = t & 31; WSP(bf16_t, WS_UG)[((size_t)g * NCH + n) * UGLD + s * 16 + cc] = f2bf(a); }
    else WSP(bf16_t, WS_GATES)[(size_t)t * 3072 + c - 2048] = f2bf(1.0f / (1.0f + expf(-(a + L.b_gate[c - 2048]))));
}
__global__ void __launch_bounds__(256) sgu_stats(Params p) {
    __shared__ float sh[8]; const int t = blockIdx.x; const bf16_t* UV = WSP(bf16_t, WS_UV); float* ST = WSP(float, WS_MERGED);
    const float a = bf2f(UV[(size_t)t * 1024 + 512 + threadIdx.x]), b = bf2f(UV[(size_t)t * 1024 + 768 + threadIdx.x]);
    float s = a + b; for (int o = 32; o >= 1; o >>= 1) s += __shfl_xor(s, o); __syncthreads(); if ((threadIdx.x & 63) == 0) sh[threadIdx.x >> 6] = s; __syncthreads(); const float mu = (sh[0] + sh[1] + sh[2] + sh[3]) / 512.f;
    float q = (a - mu) * (a - mu) + (b - mu) * (b - mu); for (int o = 32; o >= 1; o >>= 1) q += __shfl_xor(q, o); __syncthreads(); if ((threadIdx.x & 63) == 0) sh[threadIdx.x >> 6] = q; __syncthreads();
    if (threadIdx.x == 0) { ST[2 * t] = mu; ST[2 * t + 1] = rsqrtf((sh[0] + sh[1] + sh[2] + sh[3]) / 512.f + EPS); }
}
__global__ void __launch_bounds__(256) sgu_mix(Params p, int l) {
    const LayerPtrs L = layer_ptrs(p, l); const bf16_t* UV = WSP(bf16_t, WS_UV); const float* ST = WSP(float, WS_MERGED); bf16_t* YS = WSP(bf16_t, WS_YS);
    const int idx = blockIdx.x * 256 + threadIdx.x; const int t = idx >> 9, ch = idx & 511, h = ch >> 7, tl = t & 127, cb = t - tl; float s = 0.f;
    for (int sp = 0; sp <= tl; ++sp) { const float v = (bf2f(UV[(size_t)(cb + sp) * 1024 + 512 + ch]) - ST[2 * (cb + sp)]) * ST[2 * (cb + sp) + 1] * L.ln_g[ch] + L.ln_b[ch];
        s += L.sgu_w[((size_t)h * 128 + tl) * 128 + sp] * v; }
    s += L.sgu_b[h * 128 + tl];
    YS[(size_t)t * 1536 + 512 + ch] = f2bf(bf2f(UV[(size_t)t * 1024 + ch]) * s);
}
__global__ void __launch_bounds__(64) ssm(Params p, int l) {
    const LayerPtrs L = layer_ptrs(p, l); const bf16_t* UG = WSP(bf16_t, WS_UG); bf16_t* YG = WSP(bf16_t, WS_YG);
    const int b = blockIdx.x >> 5, g = blockIdx.x & 31, pp = threadIdx.x;
    const float lre = L.a_re[g * 64 + pp], lim = L.a_im[g * 64 + pp], dt = expf(L.log_dt[g]);
    const float er = expf(lre * dt); const float lbr = er * cosf(lim * dt), lbi = er * sinf(lim * dt);
    const float nr = lbr - 1.f, ni = lbi, den = lre * lre + lim * lim; const float cr = (nr * lre + ni * lim) / den, ci = (ni * lre - nr * lim) / den;
    float bbr[16], bbi[16], ccr[16], cci[16];
#pragma unroll
    for (int c = 0; c < 16; ++c) { const float br = L.b_re[(g * 64 + pp) * 16 + c], bi = L.b_im[(g * 64 + pp) * 16 + c]; bbr[c] = cr * br - ci * bi; bbi[c] = cr * bi + ci * br;
        ccr[c] = L.c_re[(g * 16 + c) * 64 + pp]; cci[c] = L.c_im[(g * 16 + c) * 64 + pp]; }
    const float dsk = L.ssm_d[g * 16 + (pp & 15)]; float xr = 0.f, xi = 0.f;
    for (int t = 0; t < SEQ; ++t) { const int tok = b * SEQ + t, n = tok >> 5, s = tok & 31; const bf16_t* row = UG + ((size_t)g * NCH + n) * UGLD + s * 16;
        float u[16];
#pragma unroll
        for (int c = 0; c < 16; ++c) u[c] = bf2f(row[c]);
        float bur = 0.f, bui = 0.f;
#pragma unroll
        for (int c = 0; c < 16; ++c) { bur += bbr[c] * u[c]; bui += bbi[c] * u[c]; }
        const float nxr = lbr * xr - lbi * xi + bur, nxi = lbr * xi + lbi * xr + bui; xr = nxr; xi = nxi; float yout = 0.f;
#pragma unroll
        for (int c = 0; c < 16; ++c) { float v = xr * ccr[c] - xi * cci[c]; for (int o = 32; o >= 1; o >>= 1) v += __shfl_xor(v, o); if (pp == c) yout = v + dsk * u[c]; }
        if (pp < 16) YG[(size_t)tok * 512 + g * 16 + pp] = f2bf(gelu_tanh_ref(yout)); }
}
__global__ void __launch_bounds__(256) glu(Params p, int l) {
    const LayerPtrs L = layer_ptrs(p, l); const int t = blockIdx.y, c = blockIdx.x * 256 + threadIdx.x; const bf16_t* YG = WSP(bf16_t, WS_YG);
    const float z = dot_bf16(YG + (size_t)t * 512, WSP(bf16_t, WS_GLU) + (size_t)c * 512, 512) + L.glu_b[c];
    WSP(bf16_t, WS_YS)[(size_t)t * 1536 + 1024 + c] = f2bf(bf2f(YG[(size_t)t * 512 + c]) / (1.0f + expf(-z)));
}
__global__ void __launch_bounds__(256) branch(Params p) {
    const int t = blockIdx.y, c = blockIdx.x * 256 + threadIdx.x; const bf16_t* YS = WSP(bf16_t, WS_YS) + (size_t)t * 1536; const bf16_t* WB = WSP(bf16_t, WS_WB) + (size_t)c * 1536; const bf16_t* G = WSP(bf16_t, WS_GATES) + (size_t)t * 3072;
    float s = 0.f;
    for (int k = 0; k < 3; ++k) s += bf2f(G[k * 1024 + c]) * dot_bf16(YS + k * 512, WB + k * 512, 512);
    WSP(bf16_t, WS_MERGED)[(size_t)t * 1024 + c] = f2bf(s);
}
__global__ void __launch_bounds__(256) wout(Params p) {
    const int t = blockIdx.y, c = blockIdx.x * 256 + threadIdx.x;
    p.out[(size_t)t * 1024 + c] += dot_bf16(WSP(bf16_t, WS_MERGED) + (size_t)t * 1024, WSP(bf16_t, WS_WOUT) + (size_t)c * 1024, 1024);
}
__global__ void __launch_bounds__(256) moe(Params p, int l) {
    __shared__ float act[512];
    const int e = blockIdx.y, pos = blockIdx.x; const unsigned n = WSP(unsigned, WS_CTL)[CW_CNT + l * 32 + e]; if ((unsigned)pos >= n) return;
    const int idx = WSP(int, WS_LIST)[(size_t)e * CAP + pos]; const float w = WSP(float, WS_LW)[(size_t)e * CAP + pos]; const int tok = idx >> 1, slot = idx & 1;
    const bf16_t* h = WSP(bf16_t, WS_HB) + (size_t)tok * 1024; const bf16_t* WGU = WSP(bf16_t, WS_WGU) + (size_t)e * 1024 * 1024; const bf16_t* WD = WSP(bf16_t, WS_WD) + (size_t)e * 1024 * 512;
    for (int j = threadIdx.x; j < 512; j += 256) { const int pn = j >> 7, jj = j & 127; const float g = dot_bf16(h, WGU + (size_t)(256 * pn + jj) * 1024, 1024), u = dot_bf16(h, WGU + (size_t)(256 * pn + 128 + jj) * 1024, 1024);
        act[j] = bf2f(f2bf(w * (g / (1.0f + expf(-g))) * u)); }
    __syncthreads();
    for (int d = threadIdx.x; d < 1024; d += 256) { float s = 0.f; const bf16_t* wr = WD + (size_t)d * 512; for (int k = 0; k < 512; ++k) s += act[k] * bf2f(wr[k]);
        WSP(bf16_t, WS_YB)[((size_t)slot * T + tok) * 1024 + d] = f2bf(s); }
}
}

enum { ST_CONV = 0, ST_PREP, ST_INPROJ, ST_MIXA, ST_SCAN, ST_SSMOUT, ST_GLU, ST_BRANCH, ST_WOUT, ST_ROUTE, ST_MOE1, ST_MOE2, ST_FINAL, ST_POOL, ST_SGU, ST_SST };

template <int STAGE>
__device__ __forceinline__ void run_stage(const Params& p, int l, int bid, int nb, LAS unsigned char* lds) {
    const LayerPtrs L = layer_ptrs(p, l);
    if constexpr (STAGE == ST_CONV) st_conv(p, l, bid, nb, lds);
    if constexpr (STAGE == ST_PREP) { if (l == 0) st_prep<false, false>(p, L.norm_mix_g, bid, nb); else st_prep<true, false>(p, L.norm_mix_g, bid, nb); }
    if constexpr (STAGE == ST_FINAL) st_prep<true, true>(p, p.in[30], bid, nb);
    if constexpr (STAGE == ST_INPROJ) { pg8::DenseOrder S; S.init(WSP(bf16_t, WS_HB), 1024, WSP(bf16_t, WS_WIN), 1024, T, INC, 1024, nb, bid);
        EpiInProj E{WSP(bf16_t, WS_PA), WSP(bf16_t, WS_UV), WSP(bf16_t, WS_UG), WSP(bf16_t, WS_GATES), L.b_gate}; pg8::gemm_phase(lds, S, E); }
    if constexpr (STAGE == ST_SST) { pg8::GroupOrder S; S.init(WSP(bf16_t, WS_UG), (size_t)NCH * UGLD * 2, UGLD, WSP(bf16_t, WS_ET), (size_t)256 * 512 * 2, 512, 32, NCH, 256, 512, nb, bid);
        EpiSst E{WSP(float, WS_SST)}; pg8::gemm_phase(lds, S, E); }
    if constexpr (STAGE == ST_POOL) st_pool(p, bid, nb);
    if constexpr (STAGE == ST_SGU) { for (int u = bid; u < 512; u += nb) sgu_unit(p, L, u, lds); }
    if constexpr (STAGE == ST_SCAN) st_scan(p, L, bid, nb);
    if constexpr (STAGE == ST_SSMOUT) { pg8::GroupOrder S; S.init(WSP(bf16_t, WS_UG), (size_t)NCH * UGLD * 2, UGLD, WSP(bf16_t, WS_TZF), (size_t)512 * UGLD * 2, UGLD, 32, NCH, 512, UGLD, nb, bid);
        EpiSsmOut E{WSP(bf16_t, WS_YG)}; pg8::gemm_phase(lds, S, E); }
    if constexpr (STAGE == ST_GLU) { pg8::DenseOrder S; S.init(WSP(bf16_t, WS_YG), 512, WSP(bf16_t, WS_GLU), 512, T, 512, 512, nb, bid);
        EpiGlu E{WSP(bf16_t, WS_YG), WSP(bf16_t, WS_YS), L.glu_b}; pg8::gemm_phase(lds, S, E); }
    if constexpr (STAGE == ST_BRANCH) { pg8::DenseOrder S; S.init(WSP(bf16_t, WS_YS), 1536, WSP(bf16_t, WS_WB), 1536, T, 1024, 512, nb, bid, 3);
        EpiBranch E{WSP(bf16_t, WS_GATES), WSP(bf16_t, WS_MERGED)}; pg8::gemm_phase(lds, S, E); }
    if constexpr (STAGE == ST_WOUT) { pg8::DenseOrder S; S.init(WSP(bf16_t, WS_MERGED), 1024, WSP(bf16_t, WS_WOUT), 1024, T, 1024, 1024, nb, bid);
        EpiWout E{p.out}; pg8::gemm_phase(lds, S, E); }
    if constexpr (STAGE == ST_ROUTE) st_route(p, L, l, bid, nb, lds);
    if constexpr (STAGE == ST_MOE1) { pg8::MoeOrder<true> S{(const char*)WSP(bf16_t, WS_HB), (const char*)WSP(bf16_t, WS_WGU), (size_t)1024 * 1024 * 2, 1024, 1024, 1024, 4, nb, bid, WSP(unsigned, WS_CTL) + CW_CNT + l * 32, WSP(int, WS_LIST)};
        EpiMoe1 E{WSP(bf16_t, WS_ACT), WSP(float, WS_LW)}; pg8::gemm_phase(lds, S, E); }
    if constexpr (STAGE == ST_MOE2) { pg8::MoeOrder<false> S{(const char*)WSP(bf16_t, WS_ACT), (const char*)WSP(bf16_t, WS_WD), (size_t)1024 * 512 * 2, 512, 512, 512, 4, nb, bid, WSP(unsigned, WS_CTL) + CW_CNT + l * 32, WSP(int, WS_LIST)};
        EpiMoe2 E{WSP(bf16_t, WS_YB), WSP(int, WS_LIST)}; pg8::gemm_phase(lds, S, E); }
}

template <int STAGE>
__global__ void __launch_bounds__(NTHREADS, 2) k_stage(Params p, int l) {
    extern __shared__ __attribute__((aligned(16))) unsigned char lds_raw[];
    run_stage<STAGE>(p, l, (int)blockIdx.x, (int)gridDim.x, (LAS unsigned char*)lds_raw);
}

template <int STAGE> static void launch_stage(const Params& p, int l, int grid, hipStream_t stream) {
    static bool attr = false;
    if (!attr) { (void)hipFuncSetAttribute((const void*)k_stage<STAGE>, hipFuncAttributeMaxDynamicSharedMemorySize, LDS_BYTES); attr = true; }
    hipLaunchKernelGGL(k_stage<STAGE>, dim3(grid), dim3(NTHREADS), LDS_BYTES, stream, p, l);
}
#define FAST(s) ((FAST_MASK >> (s)) & 1u)

extern "C" void kernel_launch(void* const* d_in, const int* in_sizes, int n_in, void* d_out, int out_size, void* d_ws, size_t ws_size, hipStream_t stream) {
    if (n_in != 31 || out_size != T * D || ws_size < WS_END) { fprintf(stderr, "kernel_launch: unexpected shapes (n_in %d out %d ws %zu need %zu)\n", n_in, out_size, ws_size, (size_t)WS_END); return; }
    Params p{};
    for (int i = 0; i < 31; ++i) p.in[i] = (const float*)d_in[i];
    p.out = (float*)d_out; p.ws = (unsigned char*)d_ws;
    const int G = 256;
    (void)hipMemsetAsync((char*)d_ws + WS_CTL, 0, 1 * MiB, stream);
    (void)hipMemcpyAsync(d_out, d_in[0], (size_t)T * D * 4, hipMemcpyDeviceToDevice, stream);
    for (int l = 0; l < 2; ++l) {
        launch_stage<ST_CONV>(p, l, G, stream);
        launch_stage<ST_PREP>(p, l, G, stream);
        if (FAST(ST_INPROJ)) launch_stage<ST_INPROJ>(p, l, G, stream); else tw::inproj<<<dim3(INC / 256, T), 256, 0, stream>>>(p, l);
        launch_stage<ST_POOL>(p, l, G, stream);
        if (FAST(ST_SGU)) launch_stage<ST_SGU>(p, l, G, stream); else { tw::sgu_stats<<<T, 256, 0, stream>>>(p); tw::sgu_mix<<<T * 512 / 256, 256, 0, stream>>>(p, l); }
        if (FAST(ST_SSMOUT)) { launch_stage<ST_SST>(p, l, G, stream); launch_stage<ST_SCAN>(p, l, G, stream); launch_stage<ST_SSMOUT>(p, l, G, stream); }
        else tw::ssm<<<128, 64, 0, stream>>>(p, l);
        if (FAST(ST_GLU)) launch_stage<ST_GLU>(p, l, G, stream); else tw::glu<<<dim3(2, T), 256, 0, stream>>>(p, l);
        if (FAST(ST_BRANCH)) launch_stage<ST_BRANCH>(p, l, G, stream); else tw::branch<<<dim3(4, T), 256, 0, stream>>>(p);
        if (FAST(ST_WOUT)) launch_stage<ST_WOUT>(p, l, G, stream); else tw::wout<<<dim3(4, T), 256, 0, stream>>>(p);
        launch_stage<ST_ROUTE>(p, l, G, stream);
        if (FAST(ST_MOE1)) { launch_stage<ST_MOE1>(p, l, G, stream); launch_stage<ST_MOE2>(p, l, G, stream); }
        else tw::moe<<<dim3(8192, 32), 256, 0, stream>>>(p, l);
    }
    launch_stage<ST_FINAL>(p, 0, G, stream);
}
```

```cpp
#include <hip/hip_runtime.h>
#include <math.h>
#include <stdio.h>

#ifndef FAST_MASK
#define FAST_MASK 0x45E4u
#endif
#ifndef ONE_LAUNCH
#define ONE_LAUNCH 1
#endif

#define LAS __attribute__((address_space(3)))
typedef unsigned short bf16_t;
typedef short bf16x8 __attribute__((ext_vector_type(8)));
typedef float f32x4 __attribute__((ext_vector_type(4)));
typedef float f32x2 __attribute__((ext_vector_type(2)));
typedef unsigned u32x4 __attribute__((ext_vector_type(4)));
typedef unsigned u32x2 __attribute__((ext_vector_type(2)));

constexpr int T = 16384, D = 1024, SEQ = 4096, INC = 5120, NE = 32, DE = 512;
constexpr int QC = 32;
constexpr int NCH = T / QC;
constexpr int UGLD = 640;
constexpr float EPS = 1e-6f;
constexpr int CAP = 32768;
constexpr int NTHREADS = 512;
constexpr int LDS_BYTES = 155648;

constexpr size_t MiB = 1u << 20;
constexpr size_t WS_CTL = 0;
constexpr size_t WS_WIN = 1 * MiB;
constexpr size_t WS_WB = WS_WIN + 10 * MiB;
constexpr size_t WS_WOUT = WS_WB + 3 * MiB;
constexpr size_t WS_GLU = WS_WOUT + 2 * MiB;
constexpr size_t WS_SGW = WS_GLU + MiB / 2;
constexpr size_t WS_ET = WS_SGW + MiB / 2;
constexpr size_t WS_TZF = WS_ET + 8 * MiB;
constexpr size_t WS_WGU = WS_TZF + 20 * MiB;
constexpr size_t WS_WD = WS_WGU + 64 * MiB;
constexpr size_t WS_HB = WS_WD + 32 * MiB;
constexpr size_t WS_PA = WS_HB + 32 * MiB;
constexpr size_t WS_UV = WS_PA + 16 * MiB;
constexpr size_t WS_UG = WS_UV + 32 * MiB;
constexpr size_t WS_YG = WS_UG + 20 * MiB;
constexpr size_t WS_SST = WS_YG + 16 * MiB;
constexpr size_t WS_MERGED = WS_SST + 8 * MiB;
constexpr size_t WS_GATES = WS_MERGED + 32 * MiB;
constexpr size_t WS_YS = WS_GATES + 96 * MiB;
constexpr size_t WS_END = WS_YS + 48 * MiB;
constexpr size_t WS_LIST = WS_GATES;
constexpr size_t WS_LW = WS_LIST + 4 * MiB;
constexpr size_t WS_ACT = WS_LW + 4 * MiB;
constexpr size_t WS_YB = WS_ACT + 40 * MiB;
static_assert(WS_YB + 64 * MiB <= WS_END, "moe overlay");
constexpr int CW_BAR = 0;
constexpr int CW_CNT = 8192;

struct Params {
    const float* in[31];
    float* out;
    unsigned char* ws;
};

__device__ __forceinline__ unsigned cvt_pk_bf16(float lo, float hi) { unsigned r; asm volatile("v_cvt_pk_bf16_f32 %0, %1, %2" : "=v"(r) : "v"(lo), "v"(hi)); return r; }
__device__ __forceinline__ bf16_t f2bf(float f) { return (bf16_t)(cvt_pk_bf16(f, 0.f) & 0xffffu); }
__device__ __forceinline__ float bf2f(bf16_t b) { return __uint_as_float(((unsigned)b) << 16); }
__device__ __forceinline__ float bflo(unsigned w) { return __uint_as_float(w << 16); }
__device__ __forceinline__ float bfhi(unsigned w) { return __uint_as_float(w & 0xffff0000u); }
__device__ __forceinline__ float fast_sigmoid(float x) { return __builtin_amdgcn_rcpf(1.0f + __builtin_amdgcn_exp2f(-1.4426950408889634f * x)); }
__device__ __forceinline__ float gelu_tanh_fast(float x) { const float z = 1.5957691216057308f * (x + 0.044715f * x * x * x); return x * fast_sigmoid(z); }
__device__ __forceinline__ float gelu_tanh_ref(float x) { return 0.5f * x * (1.0f + tanhf(0.7978845608028654f * (x + 0.044715f * x * x * x))); }
__device__ __forceinline__ float wave_sum(float v) {
    v += __int_as_float(__builtin_amdgcn_update_dpp(0, __float_as_int(v), 0xB1, 0xF, 0xF, false));
    v += __int_as_float(__builtin_amdgcn_update_dpp(0, __float_as_int(v), 0x4E, 0xF, 0xF, false));
    v += __int_as_float(__builtin_amdgcn_update_dpp(0, __float_as_int(v), 0x141, 0xF, 0xF, false));
    v += __int_as_float(__builtin_amdgcn_update_dpp(0, __float_as_int(v), 0x140, 0xF, 0xF, false));
    const int iv = __float_as_int(v);
    return (__int_as_float(__builtin_amdgcn_readlane(iv, 0)) + __int_as_float(__builtin_amdgcn_readlane(iv, 16))) + (__int_as_float(__builtin_amdgcn_readlane(iv, 32)) + __int_as_float(__builtin_amdgcn_readlane(iv, 48)));
}
__device__ __forceinline__ int opaque_tid(int wv) { unsigned m = ~0u; asm volatile("" : "+s"(m)); int t = wv * 64 + (int)__builtin_amdgcn_mbcnt_hi(m, __builtin_amdgcn_mbcnt_lo(m, 0u)); asm volatile("" : "+v"(t)); return t; }
__device__ __forceinline__ unsigned ld_agent(const unsigned* p) { return __hip_atomic_load(p, __ATOMIC_RELAXED, __HIP_MEMORY_SCOPE_AGENT); }

struct LayerPtrs {
    const float *norm_mix_g, *w_in, *b_gate, *pool_w, *pool_scale, *ln_g, *ln_b, *sgu_w, *sgu_b, *a_re, *a_im, *log_dt, *b_re, *b_im, *c_re, *c_im, *ssm_d, *glu_w, *glu_b,
        *w_branch, *w_out, *norm_ffn_g, *rgw, *rgb, *rew, *reb, *wg, *wu, *wd;
};
__device__ __host__ __forceinline__ LayerPtrs layer_ptrs(const Params& p, int l) {
    LayerPtrs q;
    q.norm_mix_g = p.in[1] + l * D; q.w_in = p.in[2] + (size_t)l * D * INC; q.b_gate = p.in[3] + l * 3 * D;
    q.pool_w = p.in[4] + (size_t)l * 4 * 128 * 128; q.pool_scale = p.in[5] + l * 512;
    q.ln_g = p.in[6] + l * 512; q.ln_b = p.in[7] + l * 512; q.sgu_w = p.in[8] + (size_t)l * 4 * 128 * 128; q.sgu_b = p.in[9] + l * 512;
    q.a_re = p.in[10] + l * 2048; q.a_im = p.in[11] + l * 2048; q.log_dt = p.in[12] + l * 32;
    q.b_re = p.in[13] + l * 32768; q.b_im = p.in[14] + l * 32768; q.c_re = p.in[15] + l * 32768; q.c_im = p.in[16] + l * 32768;
    q.ssm_d = p.in[17] + l * 512; q.glu_w = p.in[18] + (size_t)l * 512 * 512; q.glu_b = p.in[19] + l * 512;
    q.w_branch = p.in[20] + (size_t)l * 3 * 512 * 1024; q.w_out = p.in[21] + (size_t)l * D * D; q.norm_ffn_g = p.in[22] + l * D;
    q.rgw = p.in[23] + l * D * 4; q.rgb = p.in[24] + l * 4; q.rew = p.in[25] + l * D * 32; q.reb = p.in[26] + l * 32;
    q.wg = p.in[27] + (size_t)l * NE * D * DE; q.wu = p.in[28] + (size_t)l * NE * D * DE; q.wd = p.in[29] + (size_t)l * NE * DE * D;
    return q;
}
#define WSP(type, off) ((type*)(p.ws + (off)))

#define XB_TMO      128
#define XB_XCNT(j)  (256  + 64 * (j))
#define XB_XSUB(j)  (1280 + 64 * (j))
#define XB_XGEN(j)  (2304 + 64 * (j))
#define XB_TOP      3328
#define XB_TOPGEN   3392
#define XCD_BAR_WORDS 3456
#define XB_SPIN_CAP (1u << 18)

__device__ __forceinline__ unsigned xb_ld(unsigned* p)              { return __hip_atomic_load(p, __ATOMIC_RELAXED, __HIP_MEMORY_SCOPE_AGENT); }
__device__ __forceinline__ unsigned xb_add(unsigned* p, unsigned v) { return __hip_atomic_fetch_add(p, v, __ATOMIC_RELAXED, __HIP_MEMORY_SCOPE_AGENT); }
__device__ __forceinline__ unsigned xb_xcc_id() { return (unsigned)__builtin_amdgcn_s_getreg((3 << 11) | 20) & 0xFu; }
#define XB_SPIN(cond, bar) do { unsigned _sp = 0; while (cond) { __builtin_amdgcn_s_sleep(1); \
    if ((++_sp & 255u) == 0u) { if (xb_ld(&(bar)[XB_TMO])) break; if (_sp > XB_SPIN_CAP) { atomicAdd(&(bar)[XB_TMO], 1u); break; } } } } while (0)

struct XcdBarrier {
    unsigned* bar; unsigned x;
    volatile LAS unsigned* st;
    int wv;
};

__device__ __forceinline__ bool xb_thread0(int wv) { unsigned m = ~0u; asm volatile("" : "+s"(m)); return wv == 0 && __builtin_amdgcn_mbcnt_hi(m, __builtin_amdgcn_mbcnt_lo(m, 0u)) == 0u; }
__device__ __forceinline__ XcdBarrier xcd_barrier_post(unsigned* bar, volatile LAS unsigned* st, int wv) {
    XcdBarrier b; b.bar = bar; b.x = xb_xcc_id(); b.st = st; b.wv = wv;
    if (xb_thread0(wv)) (void)xb_add(&bar[XB_XCNT(b.x)], 1u);
    return b;
}
__device__ __forceinline__ void xcd_barrier_complete(unsigned* bar, unsigned x, unsigned& nloc, unsigned& nx) {
    const unsigned G = gridDim.x * gridDim.y * gridDim.z;
    unsigned sum, cnt, mine, sp = 0u;
    for (;;) {
        sum = 0u; cnt = 0u; mine = 0u;
#pragma unroll
        for (unsigned j = 0; j < 16; ++j) { const unsigned c = xb_ld(&bar[XB_XCNT(j)]); sum += c; cnt += (c > 0u) ? 1u : 0u; mine = (j == x) ? c : mine; }
        if (sum == G) break;
        __builtin_amdgcn_s_sleep(1);
        if ((++sp & 255u) == 0u) { if (xb_ld(&bar[XB_TMO])) break; if (sp > XB_SPIN_CAP) { atomicAdd(&bar[XB_TMO], 1u); break; } }
    }
    nloc = mine > 0u ? mine : 1u; nx = cnt > 0u ? cnt : 1u;
}

__device__ __forceinline__ void xcd_barrier(const XcdBarrier& b) {
    asm volatile("s_waitcnt vmcnt(0)" ::: "memory");
    __syncthreads();
    if (xb_thread0(b.wv)) {
        unsigned* bar = b.bar;
        __builtin_amdgcn_s_waitcnt(0);
        unsigned nloc = b.st[0], nx = b.st[1];
        if (nloc == 0u) { xcd_barrier_complete(bar, b.x, nloc, nx); b.st[0] = nloc; b.st[1] = nx; }
        const unsigned old = xb_add(&bar[XB_XSUB(b.x)], 1u);
        const unsigned gen = old / nloc;
        if (old + 1u == (gen + 1u) * nloc) {
            __builtin_amdgcn_fence(__ATOMIC_RELEASE, "agent");
            asm volatile("s_waitcnt vmcnt(0)" ::: "memory");
            const unsigned og = xb_add(&bar[XB_TOP], 1u);
            const unsigned tg = og / nx;
            if (og + 1u == (tg + 1u) * nx) xb_add(&bar[XB_TOPGEN], 1u);
            else XB_SPIN(xb_ld(&bar[XB_TOPGEN]) == tg, bar);
            __builtin_amdgcn_fence(__ATOMIC_ACQUIRE, "agent");
            xb_add(&bar[XB_XGEN(b.x)], 1u);
            asm volatile("s_waitcnt vmcnt(0)" ::: "memory");
        } else {
            XB_SPIN(xb_ld(&bar[XB_XGEN(b.x)]) == gen, bar);
            __builtin_amdgcn_fence(__ATOMIC_ACQUIRE, "agent");
            asm volatile("s_waitcnt vmcnt(0)" ::: "memory");
        }
    }
    __syncthreads();
}


namespace pg8 {
constexpr int BM = 256, BK = 64, HALF = 128, HTB = HALF * BK * 2, STAGE_BYTES = 8 * HTB;
__host__ __device__ __forceinline__ int lds_byte(int r, int c) { const int st = (r >> 4) * 2 + (c >> 5), rr = r & 15, cc = c & 31, ob = rr * 64 + cc * 2; return st * 1024 + (ob ^ (((ob >> 9) & 1) << 5)); }
__host__ __device__ __forceinline__ void stage_rc(int b, int& R, int& C) { const int st = b / 1024, sb = b % 1024, swz = sb ^ (((sb >> 9) & 1) << 5); R = (st >> 1) * 16 + swz / 64; C = (st & 1) * 32 + (swz % 64) / 2; }
__host__ __device__ __forceinline__ int perm32(int rho) { const int n = rho >> 4, i = rho & 15; return 8 * (i >> 2) + 4 * n + (i & 3); }
struct Unit { int pm, pn, e, p0, nvalid, prow, sub; };
template <class Epi, class Sched, bool ALIGN_EPI = true>
__device__ __forceinline__ void gemm_phase(LAS unsigned char* lds, const Sched& S, const Epi& E, int wv) {
    const int tid = opaque_tid(wv), wid = __builtin_amdgcn_readfirstlane(tid >> 6), lane = tid & 63, wr = wid >> 2, wc = wid & 3, fr = lane & 15, fq = lane >> 4;
    const int nt = S.K / BK;
    int R0, C0, R1, C1; stage_rc(tid * 16, R0, C0); stage_rc(tid * 16 + 8192, R1, C1);
    const int Rb0 = Epi::PERM ? ((R0 & ~31) + perm32(R0 & 31)) : R0, Rb1 = Epi::PERM ? ((R1 & ~31) + perm32(R1 & 31)) : R1;
    const unsigned vB0 = (unsigned)(Rb0 * S.ldb + C0) * 2u, vB1 = (unsigned)(Rb1 * S.ldb + C1) * 2u;
    const size_t kstep = (size_t)(BK * 2);
    const size_t hstepB = (size_t)HALF * S.ldb * 2;
    const unsigned ldsw = (unsigned)wid * 1024u;
    const int aoff = lds_byte(wr * 64 + fr, fq * 8), boff = lds_byte(wc * 32 + fr, fq * 8);
#define PG8_SA(b, h) (((b) * 2 + (h)) * HTB)
#define PG8_SB(b, h) ((4 + (b) * 2 + (h)) * HTB)
#define PG8_STAGE2(bufoff, gbase, o0, o1) do { \
        __builtin_amdgcn_global_load_lds((const unsigned*)((const char*)(gbase) + (o0)), (LAS unsigned*)(lds + (bufoff) + ldsw), 16, 0, 0); \
        __builtin_amdgcn_global_load_lds((const unsigned*)((const char*)(gbase) + (o1)), (LAS unsigned*)(lds + (bufoff) + ldsw + 8192), 16, 0, 0); } while (0)
#define PG8_LDA(dst, b, h) do { _Pragma("unroll") for (int m = 0; m < 4; ++m) _Pragma("unroll") for (int k = 0; k < 2; ++k) dst[m][k] = *(const LAS bf16x8*)(lds + PG8_SA(b, h) + aoff + m * 2048 + k * 1024); } while (0)
#define PG8_LDB(dst, b, h) do { _Pragma("unroll") for (int n = 0; n < 2; ++n) _Pragma("unroll") for (int k = 0; k < 2; ++k) dst[n][k] = *(const LAS bf16x8*)(lds + PG8_SB(b, h) + boff + n * 2048 + k * 1024); } while (0)
#define PG8_MMA(ai, bj, At, Bt) do { __builtin_amdgcn_s_setprio(1); _Pragma("unroll") for (int m = 0; m < 4; ++m) _Pragma("unroll") for (int n = 0; n < 2; ++n) _Pragma("unroll") for (int k = 0; k < 2; ++k) \
        acc[ai][bj][m][n] = __builtin_amdgcn_mfma_f32_16x16x32_bf16(Bt[n][k], At[m][k], acc[ai][bj][m][n], 0, 0, 0); __builtin_amdgcn_s_setprio(0); } while (0)
#define PG8_WAIT_V(n) asm volatile("s_waitcnt vmcnt(" #n ")" ::: "memory")
#define PG8_WAIT_L(n) asm volatile("s_waitcnt lgkmcnt(" #n ")" ::: "memory")
#define PG8_BAR __builtin_amdgcn_s_barrier()
#define PG8_SCHED __builtin_amdgcn_sched_barrier(0)
    Unit cur, nxt; int ui = 0;
    if (!S.next(0, cur)) return;
    f32x4 acc[2][2][4][2];
#pragma unroll
    for (int a = 0; a < 2; ++a)
#pragma unroll
        for (int b = 0; b < 2; ++b)
#pragma unroll
            for (int m = 0; m < 4; ++m)
#pragma unroll
                for (int n = 0; n < 2; ++n) acc[a][b][m][n] = (f32x4){0.f, 0.f, 0.f, 0.f};
    bf16x8 At[4][2], B0[2][2], B1[2][2];
    const char* cA = S.a_base(cur); const char* cB = S.b_base(cur);
    unsigned c00 = S.a_off(cur, R0, C0), c01 = S.a_off(cur, R1, C1), c10 = S.a_off(cur, HALF + R0, C0), c11 = S.a_off(cur, HALF + R1, C1);
    PG8_STAGE2(PG8_SB(0, 0), cB, vB0, vB1); PG8_STAGE2(PG8_SB(0, 1), cB + hstepB, vB0, vB1); PG8_STAGE2(PG8_SA(0, 0), cA, c00, c01); PG8_STAGE2(PG8_SA(0, 1), cA, c10, c11);
    if (wr == 1) PG8_BAR;
    PG8_WAIT_V(2); PG8_BAR;
    PG8_STAGE2(PG8_SB(1, 0), cB + kstep, vB0, vB1); PG8_STAGE2(PG8_SA(1, 0), cA + kstep, c00, c01); PG8_STAGE2(PG8_SB(1, 1), cB + hstepB + kstep, vB0, vB1);
    PG8_WAIT_V(6); PG8_BAR;
    for (;;) {
        const bool has_next = S.next(ui + 1, nxt);
        const char* nA = has_next ? S.a_base(nxt) : cA; const char* nB = has_next ? S.b_base(nxt) : cB;
        unsigned n00 = c00, n01 = c01, n10 = c10, n11 = c11;
        if (has_next) { n00 = S.a_off(nxt, R0, C0); n01 = S.a_off(nxt, R1, C1); n10 = S.a_off(nxt, HALF + R0, C0); n11 = S.a_off(nxt, HALF + R1, C1); }
        for (int t = 0; t < nt; t += 2) {
            const bool last = (t == nt - 2);
            const char* a1 = cA + (size_t)(t + 1) * kstep;
            const char* a2 = last ? nA : cA + (size_t)(t + 2) * kstep; const char* b2 = last ? nB : cB + (size_t)(t + 2) * kstep;
            const char* a3 = a2 + kstep; const char* b3 = b2 + kstep;
            const unsigned s00 = last ? n00 : c00, s01 = last ? n01 : c01, s10 = last ? n10 : c10, s11 = last ? n11 : c11;
            PG8_LDB(B0, 0, 0); PG8_LDB(B1, 0, 1); PG8_SCHED; PG8_LDA(At, 0, 0); PG8_STAGE2(PG8_SA(1, 1), a1, c10, c11);
            PG8_WAIT_V(8); PG8_WAIT_L(0); PG8_BAR; PG8_MMA(0, 0, At, B0); PG8_MMA(0, 1, At, B1); PG8_BAR; PG8_SCHED;
            PG8_LDA(At, 0, 1); PG8_STAGE2(PG8_SB(0, 0), b2, vB0, vB1); PG8_STAGE2(PG8_SB(0, 1), b2 + hstepB, vB0, vB1); PG8_STAGE2(PG8_SA(0, 0), a2, s00, s01);
            PG8_WAIT_V(8); PG8_WAIT_L(0); PG8_BAR; PG8_MMA(1, 0, At, B0); PG8_MMA(1, 1, At, B1); PG8_BAR; PG8_SCHED;
            PG8_LDB(B0, 1, 0); PG8_LDB(B1, 1, 1); PG8_SCHED; PG8_LDA(At, 1, 0); PG8_STAGE2(PG8_SA(0, 1), a2, s10, s11);
            PG8_WAIT_V(8); PG8_WAIT_L(0); PG8_BAR; PG8_MMA(0, 0, At, B0); PG8_MMA(0, 1, At, B1); PG8_BAR; PG8_SCHED;
            PG8_LDA(At, 1, 1); PG8_STAGE2(PG8_SB(1, 0), b3, vB0, vB1); PG8_STAGE2(PG8_SB(1, 1), b3 + hstepB, vB0, vB1); PG8_STAGE2(PG8_SA(1, 0), a3, s00, s01);
            PG8_WAIT_V(8); PG8_WAIT_L(0); PG8_BAR; PG8_MMA(1, 0, At, B0); PG8_MMA(1, 1, At, B1); PG8_BAR; PG8_SCHED;
        }
        if constexpr (ALIGN_EPI) { if (wr == 0) PG8_BAR; }
        E(acc, cur, wr, wc, fr, fq);
        if (!has_next) break;
        if (!(Epi::ACCUM && cur.sub + 1 < S.nsub)) {
#pragma unroll
        for (int a = 0; a < 2; ++a)
#pragma unroll
            for (int b = 0; b < 2; ++b)
#pragma unroll
                for (int m = 0; m < 4; ++m)
#pragma unroll
                    for (int n = 0; n < 2; ++n) acc[a][b][m][n] = (f32x4){0.f, 0.f, 0.f, 0.f};
        }
        cur = nxt; cA = nA; cB = nB; c00 = n00; c01 = n01; c10 = n10; c11 = n11; ++ui;
        if constexpr (ALIGN_EPI) { if (wr == 1) PG8_BAR; }
    }
    PG8_WAIT_V(0);
    if constexpr (!ALIGN_EPI) { if (wr == 0) PG8_BAR; }
    PG8_BAR;
#undef PG8_SA
#undef PG8_SB
#undef PG8_STAGE2
#undef PG8_LDA
#undef PG8_LDB
#undef PG8_MMA
#undef PG8_WAIT_V
#undef PG8_WAIT_L
#undef PG8_BAR
#undef PG8_SCHED
}

struct DenseOrder {
    const char* A; const char* Bt; int lda, ldb, K; int nM, nN, nwg, G, c, nsub;
    __device__ void init(const void* A_, int lda_, const void* Bt_, int ldb_, int M, int N, int K_, int G_, int c_, int nsub_ = 1) { A = (const char*)A_; Bt = (const char*)Bt_; lda = lda_; ldb = ldb_; K = K_; nM = M / BM; nN = N / BM; nwg = nM * nN; G = G_; c = c_; nsub = nsub_; }
    __device__ bool next(int i, Unit& u) const {
        u.sub = i % nsub; i /= nsub;
        const long L = (long)i * G + c; if (L >= nwg) return false;
        int wgid = (int)L; { const int q = nwg / 8, r = nwg % 8, xcd = wgid % 8, off = wgid / 8; wgid = (xcd < r ? xcd * (q + 1) : r * (q + 1) + (xcd - r) * q) + off; }
        const int nig = 8 * nN, gid = wgid / nig, fm = gid * 8, gsz = (nM - fm) < 8 ? (nM - fm) : 8;
        u.pm = fm + ((wgid % nig) % gsz); u.pn = (wgid % nig) / gsz; u.e = 0; u.p0 = 0; u.nvalid = 256; u.prow = 0; return true;
    }
    __device__ __forceinline__ const char* a_base(const Unit& u) const { return A + (size_t)u.pm * BM * lda * 2 + (size_t)u.sub * K * 2; }
    __device__ __forceinline__ const char* b_base(const Unit& u) const { return Bt + (size_t)u.pn * BM * ldb * 2 + (size_t)u.sub * K * 2; }
    __device__ __forceinline__ unsigned a_off(const Unit&, int row, int col) const { return (unsigned)(row * lda + col) * 2u; }
};
struct GroupOrder {
    static constexpr int nsub = 1;
    const char* A; const char* Bt; size_t strideA, strideB; int lda, ldb, K; int nM, nN, nwg, G, c;
    __device__ void init(const void* A_, size_t sA, int lda_, const void* Bt_, size_t sB, int ldb_, int ngroups, int M, int N, int K_, int G_, int c_) {
        A = (const char*)A_; Bt = (const char*)Bt_; strideA = sA; strideB = sB; lda = lda_; ldb = ldb_; K = K_; nM = M / BM; nN = N / BM; nwg = ngroups * nM * nN; G = G_; c = c_; }
    __device__ bool next(int i, Unit& u) const {
        const long L = (long)i * G + c; if (L >= nwg) return false;
        const int per = nM * nN; u.e = (int)L / per; const int r = (int)L % per; u.pm = r / nN; u.pn = r % nN; u.p0 = 0; u.nvalid = 256; u.prow = 0; u.sub = 0; return true;
    }
    __device__ __forceinline__ const char* a_base(const Unit& u) const { return A + (size_t)u.e * strideA + (size_t)u.pm * BM * lda * 2; }
    __device__ __forceinline__ const char* b_base(const Unit& u) const { return Bt + (size_t)u.e * strideB + (size_t)u.pn * BM * ldb * 2; }
    __device__ __forceinline__ unsigned a_off(const Unit&, int row, int col) const { return (unsigned)(row * lda + col) * 2u; }
};
template <bool GATHER>
struct MoeOrder {
    static constexpr int nsub = 1;
    const char* A; const char* Bt; size_t strideB; int lda, ldb, K; int nN, G, c; const unsigned* cnt; const int* list;
    __device__ bool next(int i, Unit& u) const {
        const int uu = i * G + c; const int q = uu / nN; u.pn = uu % nN; int accp = 0; bool found = false;
        for (int e = 0; e < NE; ++e) { const int n = (int)ld_agent(cnt + e); const int np = (n + 255) >> 8;
            if (!found && q < accp + np) { u.e = e; u.p0 = (q - accp) * 256; u.nvalid = (n - u.p0) < 256 ? (n - u.p0) : 256; found = true; }
            accp += np; }
        u.pm = q; u.prow = q * 256; u.sub = 0; return found;
    }
    __device__ __forceinline__ const char* a_base(const Unit& u) const { return GATHER ? A : A + (size_t)u.prow * lda * 2; }
    __device__ __forceinline__ const char* b_base(const Unit& u) const { return Bt + (size_t)u.e * strideB + (size_t)u.pn * BM * ldb * 2; }
    __device__ __forceinline__ unsigned a_off(const Unit& u, int row, int col) const {
        if (GATHER) { int tok = 0; if (row < u.nvalid) tok = (int)ld_agent((const unsigned*)list + (size_t)u.e * CAP + u.p0 + row) >> 1; return (unsigned)(tok * lda + col) * 2u; }
        return (unsigned)(row * lda + col) * 2u;
    }
};
}

using pg8::Unit;
#define EPI_LOOP_AI_M _Pragma("unroll") for (int ai = 0; ai < 2; ++ai) _Pragma("unroll") for (int m = 0; m < 4; ++m)
__device__ __forceinline__ u32x4 pack8(const f32x4& a, const f32x4& b) { u32x4 w; w.x = cvt_pk_bf16(a[0], a[1]); w.y = cvt_pk_bf16(a[2], a[3]); w.z = cvt_pk_bf16(b[0], b[1]); w.w = cvt_pk_bf16(b[2], b[3]); return w; }
__device__ __forceinline__ void unpack8(const u32x4& w, f32x4& a, f32x4& b) { a = (f32x4){bflo(w.x), bfhi(w.x), bflo(w.y), bfhi(w.y)}; b = (f32x4){bflo(w.z), bfhi(w.z), bflo(w.w), bfhi(w.w)}; }

struct EpiInProj {
    static constexpr bool PERM = true, ACCUM = false;
    bf16_t* PA; bf16_t* UV; bf16_t* UG; bf16_t* GATES; const float* bgate;
    __device__ __forceinline__ void operator()(f32x4 (&acc)[2][2][4][2], const Unit& u, int wr, int wc, int fr, int fq) const {
        const int row0 = u.pm * 256 + wr * 64 + fr, colt = u.pn * 256 + wc * 32 + 8 * fq;
        EPI_LOOP_AI_M { const int r = row0 + ai * 128 + m * 16;
#pragma unroll
            for (int bj = 0; bj < 2; ++bj) { const int c = colt + bj * 128; f32x4 v0 = acc[ai][bj][m][0], v1 = acc[ai][bj][m][1]; bf16_t* dst;
                if (u.pn < 2) dst = PA + (size_t)r * 512 + c;
                else if (u.pn < 6) { dst = UV + (size_t)r * 1024 + (c - 512);
#pragma unroll
                    for (int j = 0; j < 4; ++j) { v0[j] = gelu_tanh_fast(v0[j]); v1[j] = gelu_tanh_fast(v1[j]); } }
                else if (u.pn < 8) { const int cs = c - 1536, g = cs >> 4, cc = cs & 15, n = r >> 5, s = r & 31; dst = UG + ((size_t)(g * NCH + n) * UGLD + s * 16 + cc); }
                else { const int cg = c - 2048; dst = GATES + (size_t)r * 3072 + cg; const f32x4 b0 = *(const f32x4*)(bgate + cg), b1 = *(const f32x4*)(bgate + cg + 4);
#pragma unroll
                    for (int j = 0; j < 4; ++j) { v0[j] = fast_sigmoid(v0[j] + b0[j]); v1[j] = fast_sigmoid(v1[j] + b1[j]); } }
                *(u32x4*)dst = pack8(v0, v1); } }
    }
};
struct EpiSst {
    static constexpr bool PERM = false, ACCUM = false;
    float* SST;
    __device__ __forceinline__ void operator()(f32x4 (&acc)[2][2][4][2], const Unit& u, int wr, int wc, int fr, int fq) const {
        const int row0 = u.pm * 256 + wr * 64 + fr, col0 = wc * 32 + 4 * fq;
        EPI_LOOP_AI_M { float* rowp = SST + ((size_t)u.e * NCH + row0 + ai * 128 + m * 16) * 128 + col0;
#pragma unroll
            for (int n = 0; n < 2; ++n) *(f32x4*)(rowp + n * 16) = acc[ai][0][m][n]; }
    }
};
struct EpiSsmOut {
    static constexpr bool PERM = true, ACCUM = false;
    bf16_t* YG;
    __device__ __forceinline__ void operator()(f32x4 (&acc)[2][2][4][2], const Unit& u, int wr, int wc, int fr, int fq) const {
        const int row0 = u.pm * 256 + wr * 64 + fr, colt = u.pn * 256 + wc * 32 + 8 * fq;
        EPI_LOOP_AI_M { const int n = row0 + ai * 128 + m * 16;
#pragma unroll
            for (int bj = 0; bj < 2; ++bj) { const int c = colt + bj * 128, t = c >> 4, cc = c & 15; f32x4 v0 = acc[ai][bj][m][0], v1 = acc[ai][bj][m][1];
#pragma unroll
                for (int j = 0; j < 4; ++j) { v0[j] = gelu_tanh_fast(v0[j]); v1[j] = gelu_tanh_fast(v1[j]); }
                *(u32x4*)(YG + (size_t)(n * QC + t) * 512 + u.e * 16 + cc) = pack8(v0, v1); } }
    }
};
struct EpiGlu {
    static constexpr bool PERM = true, ACCUM = false;
    const bf16_t* YG; bf16_t* YS; const float* gb;
    __device__ __forceinline__ void operator()(f32x4 (&acc)[2][2][4][2], const Unit& u, int wr, int wc, int fr, int fq) const {
        const int row0 = u.pm * 256 + wr * 64 + fr, colt = u.pn * 256 + wc * 32 + 8 * fq;
        EPI_LOOP_AI_M { const int r = row0 + ai * 128 + m * 16;
#pragma unroll
            for (int bj = 0; bj < 2; ++bj) { const int c = colt + bj * 128; f32x4 v0 = acc[ai][bj][m][0], v1 = acc[ai][bj][m][1], y0, y1;
                const f32x4 b0 = *(const f32x4*)(gb + c), b1 = *(const f32x4*)(gb + c + 4);
                unpack8(*(const u32x4*)(YG + (size_t)r * 512 + c), y0, y1);
#pragma unroll
                for (int j = 0; j < 4; ++j) { v0[j] = y0[j] * fast_sigmoid(v0[j] + b0[j]); v1[j] = y1[j] * fast_sigmoid(v1[j] + b1[j]); }
                *(u32x4*)(YS + (size_t)r * 1536 + 1024 + c) = pack8(v0, v1); }
            asm volatile("" ::: "memory"); }
    }
};
struct EpiBranch {
    static constexpr bool PERM = true, ACCUM = true;
    const bf16_t* GATES; bf16_t* MERGED;
    __device__ __forceinline__ void operator()(f32x4 (&acc)[2][2][4][2], const Unit& u, int wr, int wc, int fr, int fq) const {
        const int row0 = u.pm * 256 + wr * 64 + fr, colt = u.pn * 256 + wc * 32 + 8 * fq;
        if (u.sub < 2) {
            EPI_LOOP_AI_M { const int r = row0 + ai * 128 + m * 16;
#pragma unroll
                for (int bj = 0; bj < 2; ++bj) { const int c = colt + bj * 128; f32x4 a0, a1, b0, b1;
                    unpack8(*(const u32x4*)(GATES + (size_t)r * 3072 + u.sub * 1024 + c), a0, a1); unpack8(*(const u32x4*)(GATES + (size_t)r * 3072 + (u.sub + 1) * 1024 + c), b0, b1);
#pragma unroll
                    for (int j = 0; j < 4; ++j) { acc[ai][bj][m][0][j] *= a0[j] * __builtin_amdgcn_rcpf(b0[j]); acc[ai][bj][m][1][j] *= a1[j] * __builtin_amdgcn_rcpf(b1[j]); } }
                asm volatile("" ::: "memory"); }
        } else {
            EPI_LOOP_AI_M { const int r = row0 + ai * 128 + m * 16;
#pragma unroll
                for (int bj = 0; bj < 2; ++bj) { const int c = colt + bj * 128; f32x4 g0, g1;
                    unpack8(*(const u32x4*)(GATES + (size_t)r * 3072 + 2048 + c), g0, g1);
                    *(u32x4*)(MERGED + (size_t)r * 1024 + c) = pack8(acc[ai][bj][m][0] * g0, acc[ai][bj][m][1] * g1); }
                asm volatile("" ::: "memory"); }
        }
    }
};
struct EpiWout {
    static constexpr bool PERM = false, ACCUM = false;
    float* X;
    __device__ __forceinline__ void operator()(f32x4 (&acc)[2][2][4][2], const Unit& u, int wr, int wc, int fr, int fq) const {
        const int row0 = u.pm * 256 + wr * 64 + fr, col0 = u.pn * 256 + wc * 32 + 4 * fq;
        EPI_LOOP_AI_M { float* rowp = X + (size_t)(row0 + ai * 128 + m * 16) * 1024 + col0;
#pragma unroll
            for (int bj = 0; bj < 2; ++bj)
#pragma unroll
                for (int n = 0; n < 2; ++n) { f32x4* q = (f32x4*)(rowp + bj * 128 + n * 16); *q = *q + acc[ai][bj][m][n]; }
            asm volatile("" ::: "memory"); }
    }
};
struct EpiMoe1 {
    static constexpr bool PERM = true, ACCUM = false;
    bf16_t* ACT; const float* LW;
    __device__ __forceinline__ void operator()(f32x4 (&acc)[2][2][4][2], const Unit& u, int wr, int wc, int fr, int fq) const {
        const int rl0 = wr * 64 + fr, j0 = wc * 32 + 8 * fq;
        EPI_LOOP_AI_M { const int rl = rl0 + ai * 128 + m * 16; float w = 0.f;
            if (rl < u.nvalid) w = __uint_as_float(ld_agent((const unsigned*)LW + (size_t)u.e * CAP + u.p0 + rl));
            f32x4 g0 = acc[ai][0][m][0], g1 = acc[ai][0][m][1]; const f32x4 u0 = acc[ai][1][m][0], u1 = acc[ai][1][m][1];
#pragma unroll
            for (int j = 0; j < 4; ++j) { g0[j] = w * g0[j] * fast_sigmoid(g0[j]) * u0[j]; g1[j] = w * g1[j] * fast_sigmoid(g1[j]) * u1[j]; }
            *(u32x4*)(ACT + (size_t)(u.prow + rl) * 512 + u.pn * 128 + j0) = pack8(g0, g1); }
    }
};
struct EpiMoe2 {
    static constexpr bool PERM = true, ACCUM = false;
    bf16_t* YB; const int* LIST;
    __device__ __forceinline__ void operator()(f32x4 (&acc)[2][2][4][2], const Unit& u, int wr, int wc, int fr, int fq) const {
        const int rl0 = wr * 64 + fr, colt = u.pn * 256 + wc * 32 + 8 * fq;
        EPI_LOOP_AI_M { const int rl = rl0 + ai * 128 + m * 16;
            if (rl < u.nvalid) { const int idx = (int)ld_agent((const unsigned*)LIST + (size_t)u.e * CAP + u.p0 + rl); const int tok = idx >> 1, slot = idx & 1;
                bf16_t* rowp = YB + ((size_t)slot * T + tok) * 1024 + colt;
#pragma unroll
                for (int bj = 0; bj < 2; ++bj) *(u32x4*)(rowp + bj * 128) = pack8(acc[ai][bj][m][0], acc[ai][bj][m][1]); } }
    }
};

__device__ __forceinline__ void conv_tile(const float* src, int ldsrc, int k0, int n0, bf16_t* dst, int ldd, int drow0, int dcol0, LAS float* tile, int wv) {
    const int tid = opaque_tid(wv); const int r = tid >> 4, c4 = (tid & 15) * 4;
#pragma unroll
    for (int h = 0; h < 2; ++h) { const int rr = r + 32 * h; const f32x4 v = *(const f32x4*)(src + (size_t)(k0 + rr) * ldsrc + n0 + c4);
        tile[rr * 65 + c4 + 0] = v[0]; tile[rr * 65 + c4 + 1] = v[1]; tile[rr * 65 + c4 + 2] = v[2]; tile[rr * 65 + c4 + 3] = v[3]; }
    __syncthreads();
    const int j = tid >> 3, kc = (tid & 7) * 8; float v[8];
#pragma unroll
    for (int i = 0; i < 8; ++i) v[i] = tile[(kc + i) * 65 + j];
    u32x4 w; w.x = cvt_pk_bf16(v[0], v[1]); w.y = cvt_pk_bf16(v[2], v[3]); w.z = cvt_pk_bf16(v[4], v[5]); w.w = cvt_pk_bf16(v[6], v[7]);
    *(u32x4*)(dst + (size_t)(drow0 + j) * ldd + dcol0 + k0 + kc) = w;
    __syncthreads();
}
constexpr int CV_WIN = 1280, CV_WB = 256, CV_WOUT = 256, CV_GLU = 64, CV_GU = 8192, CV_DN = 4096;
constexpr int CV_TILES = CV_WIN + CV_WB + CV_WOUT + CV_GLU + CV_GU + CV_DN;
constexpr int CV_WEFF = 1024;
constexpr int CV_SGW = 128;
constexpr int CV_SSM = 128;
constexpr int CV_UNITS = CV_TILES + CV_WEFF + CV_SGW + CV_SSM;

__device__ __forceinline__ void ssm_precompute(const Params& p, const LayerPtrs& L, int g, int q, LAS unsigned char* lds, int wv);

__device__ __forceinline__ void st_conv(const Params& p, int l, int bid, int nb, LAS unsigned char* lds, int wv) {
    const LayerPtrs L = layer_ptrs(p, l);
    LAS float* tile = (LAS float*)lds;
    bf16_t* WIN = WSP(bf16_t, WS_WIN); bf16_t* WB = WSP(bf16_t, WS_WB); bf16_t* WOUT = WSP(bf16_t, WS_WOUT); bf16_t* GLU = WSP(bf16_t, WS_GLU);
    bf16_t* WGU = WSP(bf16_t, WS_WGU); bf16_t* WD = WSP(bf16_t, WS_WD); bf16_t* SGW = WSP(bf16_t, WS_SGW);
    for (int u = bid; u < CV_UNITS; u += nb) {
        int i = u;
        if (i < CV_WIN) { conv_tile(L.w_in, INC, (i & 15) * 64, (i >> 4) * 64, WIN, 1024, (i >> 4) * 64, 0, tile, wv); continue; }
        i -= CV_WIN;
        if (i < CV_WB) { const int k = 1 + (i >> 7), s = i & 127; conv_tile(L.w_branch + (size_t)k * 512 * 1024, 1024, (s & 7) * 64, (s >> 3) * 64, WB, 1536, (s >> 3) * 64, k * 512, tile, wv); continue; }
        i -= CV_WB;
        if (i < CV_WOUT) { conv_tile(L.w_out, 1024, (i & 15) * 64, (i >> 4) * 64, WOUT, 1024, (i >> 4) * 64, 0, tile, wv); continue; }
        i -= CV_WOUT;
        if (i < CV_GLU) { conv_tile(L.glu_w, 512, (i & 7) * 64, (i >> 3) * 64, GLU, 512, (i >> 3) * 64, 0, tile, wv); continue; }
        i -= CV_GLU;
        if (i < CV_GU) { const int e = i >> 8, s = i & 255, isup = s >> 7, ss = s & 127, tk = ss & 15, tn = ss >> 4; const int n0 = tn * 64;
            const float* src = (isup ? L.wu : L.wg) + (size_t)e * 1024 * 512;
            conv_tile(src, 512, tk * 64, n0, WGU + (size_t)e * 1024 * 1024, 1024, 256 * (n0 >> 7) + (n0 & 127) + (isup ? 128 : 0), 0, tile, wv); continue; }
        i -= CV_GU;
        if (i < CV_DN) { const int e = i >> 7, s = i & 127, tk = s & 7, tn = s >> 3; conv_tile(L.wd + (size_t)e * 512 * 1024, 1024, tk * 64, tn * 64, WD + (size_t)e * 1024 * 512, 512, tn * 64, 0, tile, wv); continue; }
        i -= CV_DN;
        if (i < CV_WEFF) {
            const int o = i * 512 + opaque_tid(wv); const int kk = o >> 10, n = o & 1023, g = kk >> 7, c = kk & 127; float s = 0.f;
            const float* pw = L.pool_w + ((size_t)g * 128 + c) * 128; const float* sc = L.pool_scale + g * 128; const float* wb = L.w_branch + (size_t)(g * 128) * 1024 + n;
            for (int d = 0; d < 128; ++d) s += pw[d] * sc[d] * wb[(size_t)d * 1024];
            WB[(size_t)n * 1536 + kk] = f2bf(s); continue; }
        i -= CV_WEFF;
        if (i < CV_SGW) { const int o = i * 512 + opaque_tid(wv); const int s = o & 127, t = (o >> 7) & 127; SGW[o] = (s <= t) ? f2bf(L.sgu_w[o]) : (bf16_t)0; continue; }
        i -= CV_SGW;
        ssm_precompute(p, L, i >> 2, i & 3, lds, wv);
    }
}

__device__ __forceinline__ void ssm_precompute(const Params& p, const LayerPtrs& L, int g, int q, LAS unsigned char* lds, int wv) {
    LAS f32x2* LP = (LAS f32x2*)lds; LAS f32x2* BB = (LAS f32x2*)(lds + 16896); LAS f32x2* CC = (LAS f32x2*)(lds + 16896 + 8192); LAS float* KM = (LAS float*)(lds + 16896 + 16384);
    bf16_t* ET = WSP(bf16_t, WS_ET) + (size_t)g * 256 * 512; bf16_t* TZF = WSP(bf16_t, WS_TZF) + (size_t)g * 512 * UGLD;
    const int tid = opaque_tid(wv); const float dt = expf(L.log_dt[g]);
    for (int o = tid; o < 33 * 64; o += NTHREADS) { const int j = o >> 6, pp = o & 63; const float lre = L.a_re[g * 64 + pp], lim = L.a_im[g * 64 + pp];
        const float er = expf((float)j * lre * dt); LP[o] = (f32x2){er * cosf((float)j * lim * dt), er * sinf((float)j * lim * dt)}; }
    for (int o = tid; o < 64 * 16; o += NTHREADS) { const int pp = o >> 4; const float lre = L.a_re[g * 64 + pp], lim = L.a_im[g * 64 + pp];
        const float er = expf(lre * dt), lbr = er * cosf(lim * dt), lbi = er * sinf(lim * dt); const float nr = lbr - 1.f, ni = lbi, den = lre * lre + lim * lim;
        const float cr = (nr * lre + ni * lim) / den, ci = (ni * lre - nr * lim) / den; const float br = L.b_re[(size_t)g * 1024 + o], bi = L.b_im[(size_t)g * 1024 + o];
        BB[o] = (f32x2){cr * br - ci * bi, cr * bi + ci * br}; }
    for (int o = tid; o < 16 * 64; o += NTHREADS) CC[o] = (f32x2){L.c_re[(size_t)g * 1024 + o], L.c_im[(size_t)g * 1024 + o]};
    __syncthreads();
    const int nj = 8 * q + 8;
    for (int o = tid; o < nj * 256; o += NTHREADS) { const int j = o >> 8, c = (o >> 4) & 15, c2 = o & 15; float s = 0.f;
        for (int pp = 0; pp < 64; ++pp) { const f32x2 cv = CC[c * 64 + pp], lp = LP[j * 64 + pp], bb = BB[pp * 16 + c2];
            const float mr = cv.x * lp.x - cv.y * lp.y, mi = cv.x * lp.y + cv.y * lp.x; s += mr * bb.x - mi * bb.y; }
        if (j == 0 && c == c2) s += L.ssm_d[g * 16 + c];
        KM[o] = s; }
    __syncthreads();
    for (int o = tid; o < 64 * 64; o += NTHREADS) { const int rr = 64 * q + (o >> 6), k8 = (o & 63) * 8; float v[8];
#pragma unroll
        for (int i = 0; i < 8; ++i) { float x = 0.f; if (rr < 128) { const int pp = rr >> 1, ri = rr & 1, k = k8 + i, s = k >> 4, c2 = k & 15; const f32x2 lp = LP[(31 - s) * 64 + pp], bb = BB[pp * 16 + c2];
                x = ri ? (lp.x * bb.y + lp.y * bb.x) : (lp.x * bb.x - lp.y * bb.y); } v[i] = x; }
        u32x4 w; w.x = cvt_pk_bf16(v[0], v[1]); w.y = cvt_pk_bf16(v[2], v[3]); w.z = cvt_pk_bf16(v[4], v[5]); w.w = cvt_pk_bf16(v[6], v[7]);
        *(u32x4*)(ET + (size_t)rr * 512 + k8) = w; }
    for (int o = tid; o < 128 * 80; o += NTHREADS) { const int row = 128 * q + o / 80, k8 = (o % 80) * 8, t = row >> 4, c = row & 15; float v[8];
#pragma unroll
        for (int i = 0; i < 8; ++i) { const int k = k8 + i; float x;
            if (k < 512) { const int s = k >> 4, c2 = k & 15; x = (s <= t) ? KM[(t - s) * 256 + c * 16 + c2] : 0.f; }
            else { const int kk = k - 512, pp = kk >> 1, ri = kk & 1; const f32x2 cv = CC[c * 64 + pp], lp = LP[(t + 1) * 64 + pp];
                x = ri ? -(cv.x * lp.y + cv.y * lp.x) : (cv.x * lp.x - cv.y * lp.y); }
            v[i] = x; }
        u32x4 w; w.x = cvt_pk_bf16(v[0], v[1]); w.y = cvt_pk_bf16(v[2], v[3]); w.z = cvt_pk_bf16(v[4], v[5]); w.w = cvt_pk_bf16(v[6], v[7]);
        *(u32x4*)(TZF + (size_t)row * UGLD + k8) = w; }
    __syncthreads();
}

template <bool ADD_YB, bool FINAL, bool WRITE_X>
__device__ __forceinline__ void st_prep(const Params& p, const float* Xin, const float* gain, int bid, int nb, int wv) {
    float* X = p.out; bf16_t* HB = WSP(bf16_t, WS_HB); const bf16_t* YB = WSP(bf16_t, WS_YB);
    const int tid = opaque_tid(wv); const int wave = tid >> 6, lane = tid & 63;
    for (int t = bid * 8 + wave; t < T; t += nb * 8) {
        f32x4 v[4]; float ss = 0.f;
#pragma unroll
        for (int i = 0; i < 4; ++i) { const int c = 4 * (lane + 64 * i); v[i] = *(const f32x4*)(Xin + (size_t)t * D + c);
            if (ADD_YB) { const u32x2 a = *(const u32x2*)(YB + (size_t)t * D + c), b = *(const u32x2*)(YB + ((size_t)T + t) * D + c);
                v[i][0] += bflo(a.x) + bflo(b.x); v[i][1] += bfhi(a.x) + bfhi(b.x); v[i][2] += bflo(a.y) + bflo(b.y); v[i][3] += bfhi(a.y) + bfhi(b.y); }
            ss += v[i][0] * v[i][0] + v[i][1] * v[i][1] + v[i][2] * v[i][2] + v[i][3] * v[i][3]; }
        ss = wave_sum(ss); const float r = rsqrtf(ss / (float)D + EPS);
#pragma unroll
        for (int i = 0; i < 4; ++i) { const int c = 4 * (lane + 64 * i); const f32x4 g = *(const f32x4*)(gain + c); const f32x4 h = v[i] * r * g;
            if (FINAL) *(f32x4*)(X + (size_t)t * D + c) = h;
            else { if (WRITE_X) *(f32x4*)(X + (size_t)t * D + c) = v[i]; u32x2 w; w.x = cvt_pk_bf16(h[0], h[1]); w.y = cvt_pk_bf16(h[2], h[3]); *(u32x2*)(HB + (size_t)t * D + c) = w; } }
    }
}

__device__ __forceinline__ void st_pool(const Params& p, int bid, int nb, int wv) {
    const bf16_t* PA = WSP(bf16_t, WS_PA); bf16_t* YS = WSP(bf16_t, WS_YS);
    const int tid = opaque_tid(wv);
    for (int idx = bid * NTHREADS + tid; idx < T * 64; idx += nb * NTHREADS) {
        const int t = idx >> 6, ch = (idx & 63) * 8, g = ch >> 7, w = 2 << g, pos = t & (SEQ - 1), cnt = (pos + 1 < w) ? pos + 1 : w;
        f32x4 s0 = {0.f, 0.f, 0.f, 0.f}, s1 = s0, x0, x1;
        unpack8(*(const u32x4*)(PA + (size_t)t * 512 + ch), x0, x1); s0 = x0; s1 = x1;
        for (int j = 1; j < cnt; ++j) { f32x4 a0, a1; unpack8(*(const u32x4*)(PA + (size_t)(t - j) * 512 + ch), a0, a1); s0 = s0 + a0; s1 = s1 + a1; }
        const float inv = 1.0f / (float)cnt;
        *(u32x4*)(YS + (size_t)t * 1536 + ch) = pack8(s0 * inv - x0, s1 * inv - x1);
    }
}

__device__ __forceinline__ void sgu_unit(const Params& p, const LayerPtrs& L, int unit, LAS unsigned char* lds, int wv) {
    const bf16_t* UV = WSP(bf16_t, WS_UV); bf16_t* YS = WSP(bf16_t, WS_YS); const bf16_t* SGW = WSP(bf16_t, WS_SGW);
    LAS bf16_t* VT = (LAS bf16_t*)lds; LAS float* MU = (LAS float*)(lds + 34816); LAS float* RS = MU + 128;
    const int cb = (unit >> 2) * 128, h = unit & 3; const int tid = opaque_tid(wv), wave = tid >> 6, lane = tid & 63;
    for (int i = 0; i < 16; ++i) { const int s = wave * 16 + i; f32x4 a0, a1; unpack8(*(const u32x4*)(UV + (size_t)(cb + s) * 1024 + 512 + lane * 8), a0, a1);
        float sm = (a0[0] + a0[1]) + (a0[2] + a0[3]) + (a1[0] + a1[1]) + (a1[2] + a1[3]); sm = wave_sum(sm); const float mu = sm * (1.0f / 512.0f);
        const f32x4 d0 = a0 - mu, d1 = a1 - mu; float q = d0[0] * d0[0] + d0[1] * d0[1] + d0[2] * d0[2] + d0[3] * d0[3] + d1[0] * d1[0] + d1[1] * d1[1] + d1[2] * d1[2] + d1[3] * d1[3];
        q = wave_sum(q); if (lane == 0) { MU[s] = mu; RS[s] = rsqrtf(q * (1.0f / 512.0f) + EPS); } }
    __syncthreads();
    { const int s = tid & 127, cq = tid >> 7; const float mu = MU[s], rs = RS[s];
#pragma unroll
        for (int i = 0; i < 4; ++i) { const int c8 = (cq * 4 + i) * 8; f32x4 a0, a1; unpack8(*(const u32x4*)(UV + (size_t)(cb + s) * 1024 + 512 + h * 128 + c8), a0, a1);
            const f32x4 g0 = *(const f32x4*)(L.ln_g + h * 128 + c8), g1 = *(const f32x4*)(L.ln_g + h * 128 + c8 + 4), b0 = *(const f32x4*)(L.ln_b + h * 128 + c8), b1 = *(const f32x4*)(L.ln_b + h * 128 + c8 + 4);
            a0 = (a0 - mu) * rs * g0 + b0; a1 = (a1 - mu) * rs * g1 + b1;
#pragma unroll
            for (int j = 0; j < 4; ++j) { VT[(c8 + j) * 136 + s] = f2bf(a0[j]); VT[(c8 + 4 + j) * 136 + s] = f2bf(a1[j]); } } }
    __syncthreads();
    const int fr = lane & 15, fq = lane >> 4;
    bf16x8 A[4];
#pragma unroll
    for (int ks = 0; ks < 4; ++ks) A[ks] = *(const bf16x8*)(SGW + ((size_t)h * 128 + wave * 16 + fr) * 128 + ks * 32 + fq * 8);
    f32x4 acc[8];
#pragma unroll
    for (int n = 0; n < 8; ++n) { acc[n] = (f32x4){0.f, 0.f, 0.f, 0.f};
#pragma unroll
        for (int ks = 0; ks < 4; ++ks) { const bf16x8 B = *(const LAS bf16x8*)(VT + (n * 16 + fr) * 136 + ks * 32 + fq * 8); acc[n] = __builtin_amdgcn_mfma_f32_16x16x32_bf16(A[ks], B, acc[n], 0, 0, 0); } }
#pragma unroll
    for (int n = 0; n < 8; ++n)
#pragma unroll
        for (int r = 0; r < 4; ++r) { const int tl = wave * 16 + 4 * fq + r, ch = h * 128 + n * 16 + fr; const float sv = acc[n][r] + L.sgu_b[h * 128 + tl];
            const float uu = bf2f(UV[(size_t)(cb + tl) * 1024 + ch]); YS[(size_t)(cb + tl) * 1536 + 512 + ch] = f2bf(uu * sv); }
    __syncthreads();
}

__device__ __forceinline__ void st_scan(const Params& p, const LayerPtrs& L, int bid, int nb, int wv) {
    const float* SST = WSP(float, WS_SST); bf16_t* UG = WSP(bf16_t, WS_UG);
    const int tid = opaque_tid(wv); const int wave = tid >> 6, lane = tid & 63; const int w = bid * 8 + wave;
    if (w >= 128) return;
    const int b = w >> 5, g = w & 31; const float dt = expf(L.log_dt[g]); const float lre = L.a_re[g * 64 + lane], lim = L.a_im[g * 64 + lane];
    const float er = expf((float)QC * lre * dt); const float qr = er * cosf((float)QC * lim * dt), qi = er * sinf((float)QC * lim * dt);
    float xr = 0.f, xi = 0.f;
    for (int k = 0; k < SEQ / QC; ++k) { const int n = b * (SEQ / QC) + k;
        *(unsigned*)(UG + ((size_t)g * NCH + n) * UGLD + 512 + 2 * lane) = cvt_pk_bf16(xr, xi);
        const f32x2 s = *(const f32x2*)(SST + ((size_t)g * NCH + n) * 128 + 2 * lane);
        const float nr = qr * xr - qi * xi + s.x, ni = qr * xi + qi * xr + s.y; xr = nr; xi = ni; }
}

__device__ __forceinline__ void st_route(const Params& p, const LayerPtrs& L, int l, int bid, int nb, LAS unsigned char* lds, int wv) {
    LAS float* RW = (LAS float*)lds; const float* X = p.out; bf16_t* HB = WSP(bf16_t, WS_HB);
    unsigned* cnt = WSP(unsigned, WS_CTL) + CW_CNT + l * 32; int* LIST = WSP(int, WS_LIST); float* LW = WSP(float, WS_LW);
    const int tid = opaque_tid(wv), wave = tid >> 6, lane = tid & 63;
    for (int o = tid; o < 36 * 1024; o += NTHREADS) { const int k = o / 36, j = o % 36; RW[j * 1024 + k] = (j < 4) ? L.rgw[k * 4 + j] : L.rew[k * 32 + (j - 4)]; }
    __syncthreads();
    for (int t = bid * 8 + wave; t < T; t += nb * 8) {
        f32x4 v[4]; float ss = 0.f;
#pragma unroll
        for (int i = 0; i < 4; ++i) { const int c = 4 * (lane + 64 * i); v[i] = *(const f32x4*)(X + (size_t)t * D + c); ss += v[i][0] * v[i][0] + v[i][1] * v[i][1] + v[i][2] * v[i][2] + v[i][3] * v[i][3]; }
        ss = wave_sum(ss); const float r = rsqrtf(ss / (float)D + EPS);
#pragma unroll
        for (int i = 0; i < 4; ++i) { const int c = 4 * (lane + 64 * i); const f32x4 g = *(const f32x4*)(L.norm_ffn_g + c); v[i] = v[i] * r * g;
            u32x2 w; w.x = cvt_pk_bf16(v[i][0], v[i][1]); w.y = cvt_pk_bf16(v[i][2], v[i][3]); *(u32x2*)(HB + (size_t)t * D + c) = w; }
        float lg[36];
#pragma unroll
        for (int j = 0; j < 36; ++j) { float s = 0.f;
#pragma unroll
            for (int i = 0; i < 4; ++i) { const f32x4 w = *(const LAS f32x4*)(RW + j * 1024 + 4 * (lane + 64 * i)); s += v[i][0] * w[0] + v[i][1] * w[1] + v[i][2] * w[2] + v[i][3] * w[3]; }
            lg[j] = wave_sum(s); }
#pragma unroll
        for (int j = 0; j < 4; ++j) lg[j] += L.rgb[j];
#pragma unroll
        for (int j = 0; j < 32; ++j) lg[4 + j] += L.reb[j];
        int gi = 0; float gm = lg[0];
#pragma unroll
        for (int j = 1; j < 4; ++j) if (lg[j] > gm) { gm = lg[j]; gi = j; }
        float gs = 0.f;
#pragma unroll
        for (int j = 0; j < 4; ++j) gs += expf(lg[j] - gm);
        const float gval = 1.0f / gs;
        float el[8];
#pragma unroll
        for (int j = 0; j < 8; ++j) el[j] = gi == 0 ? lg[4 + j] : gi == 1 ? lg[12 + j] : gi == 2 ? lg[20 + j] : lg[28 + j];
        int i0 = 0; float v0 = el[0];
#pragma unroll
        for (int j = 1; j < 8; ++j) if (el[j] > v0) { v0 = el[j]; i0 = j; }
        int i1 = -1; float v1 = -INFINITY;
#pragma unroll
        for (int j = 0; j < 8; ++j) if (j != i0 && el[j] > v1) { v1 = el[j]; i1 = j; }
        const float e1 = expf(v1 - v0); const float w0 = gval / (1.f + e1), w1 = gval * e1 / (1.f + e1);
        if (lane < 2) { const int e = gi * 8 + (lane == 0 ? i0 : i1); const unsigned pos = atomicAdd(cnt + e, 1u);
            LIST[(size_t)e * CAP + pos] = t * 2 + lane; LW[(size_t)e * CAP + pos] = lane == 0 ? w0 : w1; }
    }
    __syncthreads();
}

namespace tw {
__device__ __forceinline__ float dot_bf16(const bf16_t* a, const bf16_t* b, int K) { float s = 0.f;
    for (int k = 0; k < K; k += 8) { f32x4 a0, a1, b0, b1; unpack8(*(const u32x4*)(a + k), a0, a1); unpack8(*(const u32x4*)(b + k), b0, b1);
        s += a0[0] * b0[0] + a0[1] * b0[1] + a0[2] * b0[2] + a0[3] * b0[3] + a1[0] * b1[0] + a1[1] * b1[1] + a1[2] * b1[2] + a1[3] * b1[3]; } return s; }
__global__ void __launch_bounds__(256) inproj(Params p, int l) {
    const LayerPtrs L = layer_ptrs(p, l); const int t = blockIdx.y, c = blockIdx.x * 256 + threadIdx.x;
    const float a = dot_bf16(WSP(bf16_t, WS_HB) + (size_t)t * 1024, WSP(bf16_t, WS_WIN) + (size_t)c * 1024, 1024);
    if (c < 512) WSP(bf16_t, WS_PA)[(size_t)t * 512 + c] = f2bf(a);
    else if (c < 1536) WSP(bf16_t, WS_UV)[(size_t)t * 1024 + c - 512] = f2bf(gelu_tanh_ref(a));
    else if (c < 2048) { const int cs = c - 1536, g = cs >> 4, cc = cs & 15, n = t >> 5, s = t & 31; WSP(bf16_t, WS_UG)[((size_t)g * NCH + n) * UGLD + s * 16 + cc] = f2bf(a); }
    else WSP(bf16_t, WS_GATES)[(size_t)t * 3072 + c - 2048] = f2bf(1.0f / (1.0f + expf(-(a + L.b_gate[c - 2048]))));
}
__global__ void __launch_bounds__(256) sgu_stats(Params p) {
    __shared__ float sh[8]; const int t = blockIdx.x; const bf16_t* UV = WSP(bf16_t, WS_UV); float* ST = WSP(float, WS_MERGED);
    const float a = bf2f(UV[(size_t)t * 1024 + 512 + threadIdx.x]), b = bf2f(UV[(size_t)t * 1024 + 768 + threadIdx.x]);
    float s = a + b; for (int o = 32; o >= 1; o >>= 1) s += __shfl_xor(s, o); __syncthreads(); if ((threadIdx.x & 63) == 0) sh[threadIdx.x >> 6] = s; __syncthreads(); const float mu = (sh[0] + sh[1] + sh[2] + sh[3]) / 512.f;
    float q = (a - mu) * (a - mu) + (b - mu) * (b - mu); for (int o = 32; o >= 1; o >>= 1) q += __shfl_xor(q, o); __syncthreads(); if ((threadIdx.x & 63) == 0) sh[threadIdx.x >> 6] = q; __syncthreads();
    if (threadIdx.x == 0) { ST[2 * t] = mu; ST[2 * t + 1] = rsqrtf((sh[0] + sh[1] + sh[2] + sh[3]) / 512.f + EPS); }
}
__global__ void __launch_bounds__(256) sgu_mix(Params p, int l) {
    const LayerPtrs L = layer_ptrs(p, l); const bf16_t* UV = WSP(bf16_t, WS_UV); const float* ST = WSP(float, WS_MERGED); bf16_t* YS = WSP(bf16_t, WS_YS);
    const int idx = blockIdx.x * 256 + threadIdx.x; const int t = idx >> 9, ch = idx & 511, h = ch >> 7, tl = t & 127, cb = t - tl; float s = 0.f;
    for (int sp = 0; sp <= tl; ++sp) { const float v = (bf2f(UV[(size_t)(cb + sp) * 1024 + 512 + ch]) - ST[2 * (cb + sp)]) * ST[2 * (cb + sp) + 1] * L.ln_g[ch] + L.ln_b[ch];
        s += L.sgu_w[((size_t)h * 128 + tl) * 128 + sp] * v; }
    s += L.sgu_b[h * 128 + tl];
    YS[(size_t)t * 1536 + 512 + ch] = f2bf(bf2f(UV[(size_t)t * 1024 + ch]) * s);
}
__global__ void __launch_bounds__(64) ssm(Params p, int l) {
    const LayerPtrs L = layer_ptrs(p, l); const bf16_t* UG = WSP(bf16_t, WS_UG); bf16_t* YG = WSP(bf16_t, WS_YG);
    const int b = blockIdx.x >> 5, g = blockIdx.x & 31, pp = threadIdx.x;
    const float lre = L.a_re[g * 64 + pp], lim = L.a_im[g * 64 + pp], dt = expf(L.log_dt[g]);
    const float er = expf(lre * dt); const float lbr = er * cosf(lim * dt), lbi = er * sinf(lim * dt);
    const float nr = lbr - 1.f, ni = lbi, den = lre * lre + lim * lim; const float cr = (nr * lre + ni * lim) / den, ci = (ni * lre - nr * lim) / den;
    float bbr[16], bbi[16], ccr[16], cci[16];
#pragma unroll
    for (int c = 0; c < 16; ++c) { const float br = L.b_re[(g * 64 + pp) * 16 + c], bi = L.b_im[(g * 64 + pp) * 16 + c]; bbr[c] = cr * br - ci * bi; bbi[c] = cr * bi + ci * br;
        ccr[c] = L.c_re[(g * 16 + c) * 64 + pp]; cci[c] = L.c_im[(g * 16 + c) * 64 + pp]; }
    const float dsk = L.ssm_d[g * 16 + (pp & 15)]; float xr = 0.f, xi = 0.f;
    for (int t = 0; t < SEQ; ++t) { const int tok = b * SEQ + t, n = tok >> 5, s = tok & 31; const bf16_t* row = UG + ((size_t)g * NCH + n) * UGLD + s * 16;
        float u[16];
#pragma unroll
        for (int c = 0; c < 16; ++c) u[c] = bf2f(row[c]);
        float bur = 0.f, bui = 0.f;
#pragma unroll
        for (int c = 0; c < 16; ++c) { bur += bbr[c] * u[c]; bui += bbi[c] * u[c]; }
        const float nxr = lbr * xr - lbi * xi + bur, nxi = lbr * xi + lbi * xr + bui; xr = nxr; xi = nxi; float yout = 0.f;
#pragma unroll
        for (int c = 0; c < 16; ++c) { float v = xr * ccr[c] - xi * cci[c]; for (int o = 32; o >= 1; o >>= 1) v += __shfl_xor(v, o); if (pp == c) yout = v + dsk * u[c]; }
        if (pp < 16) YG[(size_t)tok * 512 + g * 16 + pp] = f2bf(gelu_tanh_ref(yout)); }
}
__global__ void __launch_bounds__(256) glu(Params p, int l) {
    const LayerPtrs L = layer_ptrs(p, l); const int t = blockIdx.y, c = blockIdx.x * 256 + threadIdx.x; const bf16_t* YG = WSP(bf16_t, WS_YG);
    const float z = dot_bf16(YG + (size_t)t * 512, WSP(bf16_t, WS_GLU) + (size_t)c * 512, 512) + L.glu_b[c];
    WSP(bf16_t, WS_YS)[(size_t)t * 1536 + 1024 + c] = f2bf(bf2f(YG[(size_t)t * 512 + c]) / (1.0f + expf(-z)));
}
__global__ void __launch_bounds__(256) branch(Params p) {
    const int t = blockIdx.y, c = blockIdx.x * 256 + threadIdx.x; const bf16_t* YS = WSP(bf16_t, WS_YS) + (size_t)t * 1536; const bf16_t* WB = WSP(bf16_t, WS_WB) + (size_t)c * 1536; const bf16_t* G = WSP(bf16_t, WS_GATES) + (size_t)t * 3072;
    float s = 0.f;
    for (int k = 0; k < 3; ++k) s += bf2f(G[k * 1024 + c]) * dot_bf16(YS + k * 512, WB + k * 512, 512);
    WSP(bf16_t, WS_MERGED)[(size_t)t * 1024 + c] = f2bf(s);
}
__global__ void __launch_bounds__(256) wout(Params p) {
    const int t = blockIdx.y, c = blockIdx.x * 256 + threadIdx.x;
    p.out[(size_t)t * 1024 + c] += dot_bf16(WSP(bf16_t, WS_MERGED) + (size_t)t * 1024, WSP(bf16_t, WS_WOUT) + (size_t)c * 1024, 1024);
}
__global__ void __launch_bounds__(256) moe(Params p, int l) {
    __shared__ float act[512];
    const int e = blockIdx.y, pos = blockIdx.x; const unsigned n = WSP(unsigned, WS_CTL)[CW_CNT + l * 32 + e]; if ((unsigned)pos >= n) return;
    const int idx = WSP(int, WS_LIST)[(size_t)e * CAP + pos]; const float w = WSP(float, WS_LW)[(size_t)e * CAP + pos]; const int tok = idx >> 1, slot = idx & 1;
    const bf16_t* h = WSP(bf16_t, WS_HB) + (size_t)tok * 1024; const bf16_t* WGU = WSP(bf16_t, WS_WGU) + (size_t)e * 1024 * 1024; const bf16_t* WD = WSP(bf16_t, WS_WD) + (size_t)e * 1024 * 512;
    for (int j = threadIdx.x; j < 512; j += 256) { const int pn = j >> 7, jj = j & 127; const float g = dot_bf16(h, WGU + (size_t)(256 * pn + jj) * 1024, 1024), u = dot_bf16(h, WGU + (size_t)(256 * pn + 128 + jj) * 1024, 1024);
        act[j] = bf2f(f2bf(w * (g / (1.0f + expf(-g))) * u)); }
    __syncthreads();
    for (int d = threadIdx.x; d < 1024; d += 256) { float s = 0.f; const bf16_t* wr = WD + (size_t)d * 512; for (int k = 0; k < 512; ++k) s += act[k] * bf2f(wr[k]);
        WSP(bf16_t, WS_YB)[((size_t)slot * T + tok) * 1024 + d] = f2bf(s); }
}
}

enum { ST_CONV = 0, ST_PREP, ST_INPROJ, ST_MIXA, ST_SCAN, ST_SSMOUT, ST_GLU, ST_BRANCH, ST_WOUT, ST_ROUTE, ST_MOE1, ST_MOE2, ST_FINAL, ST_POOL, ST_SGU, ST_SST };

template <int STAGE>
__device__ __forceinline__ void run_stage(const Params& p_arg, int l, int bid, int nb, LAS unsigned char* lds, int wv) {
    asm volatile("" : "+s"(l));
    Params p;
#if defined(__HIP_DEVICE_COMPILE__)
    typedef const Params __attribute__((address_space(4))) KParams;
    const KParams* kp = (const KParams*)__builtin_amdgcn_kernarg_segment_ptr(); asm volatile("" : "+s"(kp));
#pragma unroll
    for (int i = 0; i < 31; ++i) p.in[i] = kp->in[i];
    p.out = kp->out; p.ws = kp->ws; (void)p_arg;
#else
    p = p_arg;
#endif
    const LayerPtrs L = layer_ptrs(p, l);
    if constexpr (STAGE == ST_CONV) st_conv(p, l, bid, nb, lds, wv);
    if constexpr (STAGE == ST_PREP) { if (l == 0) st_prep<false, false, true>(p, p.in[0], L.norm_mix_g, bid, nb, wv); else st_prep<true, false, true>(p, p.out, L.norm_mix_g, bid, nb, wv); }
    if constexpr (STAGE == ST_FINAL) st_prep<true, true, false>(p, p.out, p.in[30], bid, nb, wv);
    if constexpr (STAGE == ST_INPROJ) { pg8::DenseOrder S; S.init(WSP(bf16_t, WS_HB), 1024, WSP(bf16_t, WS_WIN), 1024, T, INC, 1024, nb, bid);
        EpiInProj E{WSP(bf16_t, WS_PA), WSP(bf16_t, WS_UV), WSP(bf16_t, WS_UG), WSP(bf16_t, WS_GATES), L.b_gate}; pg8::gemm_phase(lds, S, E, wv); }
    if constexpr (STAGE == ST_SST) { pg8::GroupOrder S; S.init(WSP(bf16_t, WS_UG), (size_t)NCH * UGLD * 2, UGLD, WSP(bf16_t, WS_ET), (size_t)256 * 512 * 2, 512, 32, NCH, 256, 512, nb, bid);
        EpiSst E{WSP(float, WS_SST)}; pg8::gemm_phase(lds, S, E, wv); }
    if constexpr (STAGE == ST_POOL) st_pool(p, bid, nb, wv);
    if constexpr (STAGE == ST_SGU) { for (int u = bid; u < 512; u += nb) sgu_unit(p, L, u, lds, wv); }
    if constexpr (STAGE == ST_SCAN) st_scan(p, L, bid, nb, wv);
    if constexpr (STAGE == ST_SSMOUT) { pg8::GroupOrder S; S.init(WSP(bf16_t, WS_UG), (size_t)NCH * UGLD * 2, UGLD, WSP(bf16_t, WS_TZF), (size_t)512 * UGLD * 2, UGLD, 32, NCH, 512, UGLD, nb, bid);
        EpiSsmOut E{WSP(bf16_t, WS_YG)}; pg8::gemm_phase(lds, S, E, wv); }
    if constexpr (STAGE == ST_GLU) { pg8::DenseOrder S; S.init(WSP(bf16_t, WS_YG), 512, WSP(bf16_t, WS_GLU), 512, T, 512, 512, nb, bid);
        EpiGlu E{WSP(bf16_t, WS_YG), WSP(bf16_t, WS_YS), L.glu_b}; pg8::gemm_phase(lds, S, E, wv); }
    if constexpr (STAGE == ST_BRANCH) { pg8::DenseOrder S; S.init(WSP(bf16_t, WS_YS), 1536, WSP(bf16_t, WS_WB), 1536, T, 1024, 512, nb, bid, 3);
        EpiBranch E{WSP(bf16_t, WS_GATES), WSP(bf16_t, WS_MERGED)}; pg8::gemm_phase(lds, S, E, wv); }
    if constexpr (STAGE == ST_WOUT) { pg8::DenseOrder S; S.init(WSP(bf16_t, WS_MERGED), 1024, WSP(bf16_t, WS_WOUT), 1024, T, 1024, 1024, nb, bid);
        EpiWout E{p.out}; pg8::gemm_phase(lds, S, E, wv); }
    if constexpr (STAGE == ST_ROUTE) st_route(p, L, l, bid, nb, lds, wv);
    if constexpr (STAGE == ST_MOE1) { pg8::MoeOrder<true> S{(const char*)WSP(bf16_t, WS_HB), (const char*)WSP(bf16_t, WS_WGU), (size_t)1024 * 1024 * 2, 1024, 1024, 1024, 4, nb, bid, WSP(unsigned, WS_CTL) + CW_CNT + l * 32, WSP(int, WS_LIST)};
        EpiMoe1 E{WSP(bf16_t, WS_ACT), WSP(float, WS_LW)}; pg8::gemm_phase(lds, S, E, wv); }
    if constexpr (STAGE == ST_MOE2) { pg8::MoeOrder<false> S{(const char*)WSP(bf16_t, WS_ACT), (const char*)WSP(bf16_t, WS_WD), (size_t)1024 * 512 * 2, 512, 512, 512, 4, nb, bid, WSP(unsigned, WS_CTL) + CW_CNT + l * 32, WSP(int, WS_LIST)};
        EpiMoe2 E{WSP(bf16_t, WS_YB), WSP(int, WS_LIST)}; pg8::gemm_phase(lds, S, E, wv); }
}

template <int STAGE>
__global__ void __launch_bounds__(NTHREADS, 2) k_stage(Params p, int l) {
    extern __shared__ __attribute__((aligned(16))) unsigned char lds_raw[];
    run_stage<STAGE>(p, l, (int)blockIdx.x, (int)gridDim.x, (LAS unsigned char*)lds_raw, __builtin_amdgcn_readfirstlane((int)threadIdx.x >> 6));
}


__global__ void __launch_bounds__(NTHREADS, 2) k_mega(Params p) {
    extern __shared__ __attribute__((aligned(16))) unsigned char lds_raw[];
    LAS unsigned char* lds = (LAS unsigned char*)lds_raw;
    volatile LAS unsigned* xbw = (volatile LAS unsigned*)(lds + LDS_BYTES - 16);
    if (threadIdx.x < 4) xbw[threadIdx.x] = 0u;
    const int bid = (int)blockIdx.x, nb = (int)gridDim.x, wv = __builtin_amdgcn_readfirstlane((int)threadIdx.x >> 6);
    __syncthreads();
    XcdBarrier bar = xcd_barrier_post(WSP(unsigned, WS_CTL) + CW_BAR, xbw, wv);
#define MK_LAYER(l) do { \
        run_stage<ST_CONV>(p, l, bid, nb, lds, wv); run_stage<ST_PREP>(p, l, bid, nb, lds, wv); xcd_barrier(bar); \
        run_stage<ST_INPROJ>(p, l, bid, nb, lds, wv); xcd_barrier(bar); \
        run_stage<ST_SST>(p, l, bid, nb, lds, wv); run_stage<ST_POOL>(p, l, bid, nb, lds, wv); run_stage<ST_SGU>(p, l, bid, nb, lds, wv); xcd_barrier(bar); \
        run_stage<ST_SCAN>(p, l, bid, nb, lds, wv); xcd_barrier(bar); \
        run_stage<ST_SSMOUT>(p, l, bid, nb, lds, wv); xcd_barrier(bar); \
        run_stage<ST_GLU>(p, l, bid, nb, lds, wv); xcd_barrier(bar); \
        run_stage<ST_BRANCH>(p, l, bid, nb, lds, wv); xcd_barrier(bar); \
        run_stage<ST_WOUT>(p, l, bid, nb, lds, wv); xcd_barrier(bar); \
        run_stage<ST_ROUTE>(p, l, bid, nb, lds, wv); xcd_barrier(bar); \
        run_stage<ST_MOE1>(p, l, bid, nb, lds, wv); xcd_barrier(bar); \
        run_stage<ST_MOE2>(p, l, bid, nb, lds, wv); xcd_barrier(bar); \
    } while (0)
    MK_LAYER(0);
    MK_LAYER(1);
#undef MK_LAYER
    run_stage<ST_FINAL>(p, 0, bid, nb, lds, wv);
}

template <int STAGE> static void launch_stage(const Params& p, int l, int grid, hipStream_t stream) {
    static bool attr = false;
    if (!attr) { (void)hipFuncSetAttribute((const void*)k_stage<STAGE>, hipFuncAttributeMaxDynamicSharedMemorySize, LDS_BYTES); attr = true; }
    hipLaunchKernelGGL(k_stage<STAGE>, dim3(grid), dim3(NTHREADS), LDS_BYTES, stream, p, l);
}
#define FAST(s) ((FAST_MASK >> (s)) & 1u)

extern "C" void kernel_launch(void* const* d_in, const int* in_sizes, int n_in, void* d_out, int out_size, void* d_ws, size_t ws_size, hipStream_t stream) {
    if (n_in != 31 || out_size != T * D || ws_size < WS_END) { fprintf(stderr, "kernel_launch: unexpected shapes (n_in %d out %d ws %zu need %zu)\n", n_in, out_size, ws_size, (size_t)WS_END); return; }
    Params p{};
    for (int i = 0; i < 31; ++i) p.in[i] = (const float*)d_in[i];
    p.out = (float*)d_out; p.ws = (unsigned char*)d_ws;
    (void)hipMemsetAsync((char*)d_ws + WS_CTL, 0, 1 * MiB, stream);
#if ONE_LAUNCH
    static int grid = 0;
    if (!grid) {
        int dev = 0, cus = 0, per_cu = 0;
        (void)hipGetDevice(&dev); (void)hipDeviceGetAttribute(&cus, hipDeviceAttributeMultiprocessorCount, dev);
        (void)hipFuncSetAttribute((const void*)k_mega, hipFuncAttributeMaxDynamicSharedMemorySize, LDS_BYTES);
        if (hipOccupancyMaxActiveBlocksPerMultiprocessor(&per_cu, (const void*)k_mega, NTHREADS, LDS_BYTES) != hipSuccess || per_cu < 1) { fprintf(stderr, "kernel_launch: occupancy query says %d blocks per CU\n", per_cu); (void)hipGetLastError(); }
        grid = cus > 0 ? cus : 256;
    }
    hipLaunchKernelGGL(k_mega, dim3(grid), dim3(NTHREADS), LDS_BYTES, stream, p);
    return;
#endif
    const int G = 256;
    for (int l = 0; l < 2; ++l) {
        launch_stage<ST_CONV>(p, l, G, stream);
        launch_stage<ST_PREP>(p, l, G, stream);
        if (FAST(ST_INPROJ)) launch_stage<ST_INPROJ>(p, l, G, stream); else tw::inproj<<<dim3(INC / 256, T), 256, 0, stream>>>(p, l);
        launch_stage<ST_POOL>(p, l, G, stream);
        if (FAST(ST_SGU)) launch_stage<ST_SGU>(p, l, G, stream); else { tw::sgu_stats<<<T, 256, 0, stream>>>(p); tw::sgu_mix<<<T * 512 / 256, 256, 0, stream>>>(p, l); }
        if (FAST(ST_SSMOUT)) { launch_stage<ST_SST>(p, l, G, stream); launch_stage<ST_SCAN>(p, l, G, stream); launch_stage<ST_SSMOUT>(p, l, G, stream); }
        else tw::ssm<<<128, 64, 0, stream>>>(p, l);
        if (FAST(ST_GLU)) launch_stage<ST_GLU>(p, l, G, stream); else tw::glu<<<dim3(2, T), 256, 0, stream>>>(p, l);
        if (FAST(ST_BRANCH)) launch_stage<ST_BRANCH>(p, l, G, stream); else tw::branch<<<dim3(4, T), 256, 0, stream>>>(p);
        if (FAST(ST_WOUT)) launch_stage<ST_WOUT>(p, l, G, stream); else tw::wout<<<dim3(4, T), 256, 0, stream>>>(p);
        launch_stage<ST_ROUTE>(p, l, G, stream);
        if (FAST(ST_MOE1)) { launch_stage<ST_MOE1>(p, l, G, stream); launch_stage<ST_MOE2>(p, l, G, stream); }
        else tw::moe<<<dim3(8192, 32), 256, 0, stream>>>(p, l);
    }
    launch_stage<ST_FINAL>(p, 0, G, stream);
}
```

```cpp
#include <hip/hip_runtime.h>
#include <math.h>
#include <stdio.h>

#ifndef FAST_MASK
#define FAST_MASK 0x45E4u
#endif
#ifndef DBL_MASK
#define DBL_MASK 0x0u
#endif
#ifndef ONE_LAUNCH
#define ONE_LAUNCH 1
#endif

#define LAS __attribute__((address_space(3)))
typedef unsigned short bf16_t;
typedef short bf16x8 __attribute__((ext_vector_type(8)));
typedef float f32x4 __attribute__((ext_vector_type(4)));
typedef float f32x2 __attribute__((ext_vector_type(2)));
typedef unsigned u32x4 __attribute__((ext_vector_type(4)));
typedef unsigned u32x2 __attribute__((ext_vector_type(2)));

constexpr int T = 16384, D = 1024, SEQ = 4096, INC = 5120, NE = 32, DE = 512;
constexpr int QC = 32;
constexpr int NCH = T / QC;
constexpr int UGLD = 640;
constexpr float EPS = 1e-6f;
constexpr int CAP = 32768;
constexpr int NTHREADS = 512;
constexpr int LDS_BYTES = 155648;

constexpr size_t MiB = 1u << 20;
constexpr size_t WS_CTL = 0;
constexpr size_t WS_WIN = 1 * MiB;
constexpr size_t WS_WB = WS_WIN + 10 * MiB;
constexpr size_t WS_WOUT = WS_WB + 3 * MiB;
constexpr size_t WS_GLU = WS_WOUT + 2 * MiB;
constexpr size_t WS_SGW = WS_GLU + MiB / 2;
constexpr size_t WS_ET = WS_SGW + MiB / 2;
constexpr size_t WS_TZF = WS_ET + 8 * MiB;
constexpr size_t WS_WGU = WS_TZF + 20 * MiB;
constexpr size_t WS_WD = WS_WGU + 64 * MiB;
constexpr size_t WS_HB = WS_WD + 32 * MiB;
constexpr size_t WS_PA = WS_HB + 32 * MiB;
constexpr size_t WS_UV = WS_PA + 16 * MiB;
constexpr size_t WS_UG = WS_UV + 32 * MiB;
constexpr size_t WS_YG = WS_UG + 20 * MiB;
constexpr size_t WS_SST = WS_YG + 16 * MiB;
constexpr size_t WS_MERGED = WS_SST + 8 * MiB;
constexpr size_t WS_GATES = WS_MERGED + 32 * MiB;
constexpr size_t WS_YS = WS_GATES + 96 * MiB;
constexpr size_t WS_END = WS_YS + 48 * MiB;
constexpr size_t WS_LIST = WS_GATES;
constexpr size_t WS_LW = WS_LIST + 4 * MiB;
constexpr size_t WS_ACT = WS_LW + 4 * MiB;
constexpr size_t WS_YB = WS_ACT + 40 * MiB;
static_assert(WS_YB + 64 * MiB <= WS_END, "moe overlay");
constexpr int CW_BAR = 0;
constexpr int CW_CNT = 8192, CNT_STRIDE = 64;

struct Params {
    const float* in[31];
    float* out;
    unsigned char* ws;
};

__device__ __forceinline__ unsigned cvt_pk_bf16(float lo, float hi) { unsigned r; asm volatile("v_cvt_pk_bf16_f32 %0, %1, %2" : "=v"(r) : "v"(lo), "v"(hi)); return r; }
__device__ __forceinline__ bf16_t f2bf(float f) { return (bf16_t)(cvt_pk_bf16(f, 0.f) & 0xffffu); }
__device__ __forceinline__ float bf2f(bf16_t b) { return __uint_as_float(((unsigned)b) << 16); }
__device__ __forceinline__ float bflo(unsigned w) { return __uint_as_float(w << 16); }
__device__ __forceinline__ float bfhi(unsigned w) { return __uint_as_float(w & 0xffff0000u); }
__device__ __forceinline__ float fast_sigmoid(float x) { return __builtin_amdgcn_rcpf(1.0f + __builtin_amdgcn_exp2f(-1.4426950408889634f * x)); }
__device__ __forceinline__ float gelu_tanh_fast(float x) { const float z = 1.5957691216057308f * (x + 0.044715f * x * x * x); return x * fast_sigmoid(z); }
__device__ __forceinline__ float gelu_tanh_ref(float x) { return 0.5f * x * (1.0f + tanhf(0.7978845608028654f * (x + 0.044715f * x * x * x))); }
__device__ __forceinline__ float wave_sum(float v) {
    v += __int_as_float(__builtin_amdgcn_update_dpp(0, __float_as_int(v), 0xB1, 0xF, 0xF, false));
    v += __int_as_float(__builtin_amdgcn_update_dpp(0, __float_as_int(v), 0x4E, 0xF, 0xF, false));
    v += __int_as_float(__builtin_amdgcn_update_dpp(0, __float_as_int(v), 0x141, 0xF, 0xF, false));
    v += __int_as_float(__builtin_amdgcn_update_dpp(0, __float_as_int(v), 0x140, 0xF, 0xF, false));
    const int iv = __float_as_int(v);
    return (__int_as_float(__builtin_amdgcn_readlane(iv, 0)) + __int_as_float(__builtin_amdgcn_readlane(iv, 16))) + (__int_as_float(__builtin_amdgcn_readlane(iv, 32)) + __int_as_float(__builtin_amdgcn_readlane(iv, 48)));
}
__device__ __forceinline__ int opaque_tid(int wv) { unsigned m = ~0u; asm volatile("" : "+s"(m)); int t = wv * 64 + (int)__builtin_amdgcn_mbcnt_hi(m, __builtin_amdgcn_mbcnt_lo(m, 0u)); asm volatile("" : "+v"(t)); return t; }
__device__ __forceinline__ unsigned ld_agent(const unsigned* p) { return __hip_atomic_load(p, __ATOMIC_RELAXED, __HIP_MEMORY_SCOPE_AGENT); }

struct LayerPtrs {
    const float *norm_mix_g, *w_in, *b_gate, *pool_w, *pool_scale, *ln_g, *ln_b, *sgu_w, *sgu_b, *a_re, *a_im, *log_dt, *b_re, *b_im, *c_re, *c_im, *ssm_d, *glu_w, *glu_b,
        *w_branch, *w_out, *norm_ffn_g, *rgw, *rgb, *rew, *reb, *wg, *wu, *wd;
};
__device__ __host__ __forceinline__ LayerPtrs layer_ptrs(const Params& p, int l) {
    LayerPtrs q;
    q.norm_mix_g = p.in[1] + l * D; q.w_in = p.in[2] + (size_t)l * D * INC; q.b_gate = p.in[3] + l * 3 * D;
    q.pool_w = p.in[4] + (size_t)l * 4 * 128 * 128; q.pool_scale = p.in[5] + l * 512;
    q.ln_g = p.in[6] + l * 512; q.ln_b = p.in[7] + l * 512; q.sgu_w = p.in[8] + (size_t)l * 4 * 128 * 128; q.sgu_b = p.in[9] + l * 512;
    q.a_re = p.in[10] + l * 2048; q.a_im = p.in[11] + l * 2048; q.log_dt = p.in[12] + l * 32;
    q.b_re = p.in[13] + l * 32768; q.b_im = p.in[14] + l * 32768; q.c_re = p.in[15] + l * 32768; q.c_im = p.in[16] + l * 32768;
    q.ssm_d = p.in[17] + l * 512; q.glu_w = p.in[18] + (size_t)l * 512 * 512; q.glu_b = p.in[19] + l * 512;
    q.w_branch = p.in[20] + (size_t)l * 3 * 512 * 1024; q.w_out = p.in[21] + (size_t)l * D * D; q.norm_ffn_g = p.in[22] + l * D;
    q.rgw = p.in[23] + l * D * 4; q.rgb = p.in[24] + l * 4; q.rew = p.in[25] + l * D * 32; q.reb = p.in[26] + l * 32;
    q.wg = p.in[27] + (size_t)l * NE * D * DE; q.wu = p.in[28] + (size_t)l * NE * D * DE; q.wd = p.in[29] + (size_t)l * NE * DE * D;
    return q;
}
#define WSP(type, off) ((type*)(p.ws + (off)))

#define XB_TMO      128
#define XB_XCNT(j)  (256  + 64 * (j))
#define XB_XSUB(j)  (1280 + 64 * (j))
#define XB_XGEN(j)  (2304 + 64 * (j))
#define XB_TOP      3328
#define XB_TOPGEN   3392
#define XCD_BAR_WORDS 3456
#define XB_SPIN_CAP (1u << 18)

__device__ __forceinline__ unsigned xb_ld(unsigned* p)              { return __hip_atomic_load(p, __ATOMIC_RELAXED, __HIP_MEMORY_SCOPE_AGENT); }
__device__ __forceinline__ unsigned xb_add(unsigned* p, unsigned v) { return __hip_atomic_fetch_add(p, v, __ATOMIC_RELAXED, __HIP_MEMORY_SCOPE_AGENT); }
__device__ __forceinline__ unsigned xb_xcc_id() { return (unsigned)__builtin_amdgcn_s_getreg((3 << 11) | 20) & 0xFu; }
#define XB_SPIN(cond, bar) do { unsigned _sp = 0; while (cond) { __builtin_amdgcn_s_sleep(1); \
    if ((++_sp & 255u) == 0u) { if (xb_ld(&(bar)[XB_TMO])) break; if (_sp > XB_SPIN_CAP) { atomicAdd(&(bar)[XB_TMO], 1u); break; } } } } while (0)

struct XcdBarrier {
    unsigned* bar; unsigned x;
    volatile LAS unsigned* st;
    int wv;
};

__device__ __forceinline__ bool xb_thread0(int wv) { unsigned m = ~0u; asm volatile("" : "+s"(m)); return wv == 0 && __builtin_amdgcn_mbcnt_hi(m, __builtin_amdgcn_mbcnt_lo(m, 0u)) == 0u; }
__device__ __forceinline__ XcdBarrier xcd_barrier_post(unsigned* bar, volatile LAS unsigned* st, int wv) {
    XcdBarrier b; b.bar = bar; b.x = xb_xcc_id(); b.st = st; b.wv = wv;
    if (xb_thread0(wv)) (void)xb_add(&bar[XB_XCNT(b.x)], 1u);
    return b;
}
__device__ __forceinline__ void xcd_barrier_complete(unsigned* bar, unsigned x, unsigned& nloc, unsigned& nx) {
    const unsigned G = gridDim.x * gridDim.y * gridDim.z;
    unsigned sum, cnt, mine, sp = 0u;
    for (;;) {
        sum = 0u; cnt = 0u; mine = 0u;
#pragma unroll
        for (unsigned j = 0; j < 16; ++j) { const unsigned c = xb_ld(&bar[XB_XCNT(j)]); sum += c; cnt += (c > 0u) ? 1u : 0u; mine = (j == x) ? c : mine; }
        if (sum == G) break;
        __builtin_amdgcn_s_sleep(1);
        if ((++sp & 255u) == 0u) { if (xb_ld(&bar[XB_TMO])) break; if (sp > XB_SPIN_CAP) { atomicAdd(&bar[XB_TMO], 1u); break; } }
    }
    nloc = mine > 0u ? mine : 1u; nx = cnt > 0u ? cnt : 1u;
}

__device__ __forceinline__ void xcd_barrier(const XcdBarrier& b) {
    asm volatile("s_waitcnt vmcnt(0)" ::: "memory");
    __syncthreads();
    if (xb_thread0(b.wv)) {
        unsigned* bar = b.bar;
        __builtin_amdgcn_s_waitcnt(0);
        unsigned nloc = b.st[0], nx = b.st[1];
        if (nloc == 0u) { xcd_barrier_complete(bar, b.x, nloc, nx); b.st[0] = nloc; b.st[1] = nx; }
        const unsigned old = xb_add(&bar[XB_XSUB(b.x)], 1u);
        const unsigned gen = old / nloc;
        if (old + 1u == (gen + 1u) * nloc) {
            __builtin_amdgcn_fence(__ATOMIC_RELEASE, "agent");
            asm volatile("s_waitcnt vmcnt(0)" ::: "memory");
            const unsigned og = xb_add(&bar[XB_TOP], 1u);
            const unsigned tg = og / nx;
            if (og + 1u == (tg + 1u) * nx) xb_add(&bar[XB_TOPGEN], 1u);
            else XB_SPIN(xb_ld(&bar[XB_TOPGEN]) == tg, bar);
            __builtin_amdgcn_fence(__ATOMIC_ACQUIRE, "agent");
            xb_add(&bar[XB_XGEN(b.x)], 1u);
            asm volatile("s_waitcnt vmcnt(0)" ::: "memory");
        } else {
            XB_SPIN(xb_ld(&bar[XB_XGEN(b.x)]) == gen, bar);
            __builtin_amdgcn_fence(__ATOMIC_ACQUIRE, "agent");
            asm volatile("s_waitcnt vmcnt(0)" ::: "memory");
        }
    }
    __syncthreads();
}


namespace pg8 {
constexpr int BM = 256, BK = 64, HALF = 128, HTB = HALF * BK * 2, STAGE_BYTES = 8 * HTB;
__host__ __device__ __forceinline__ int lds_byte(int r, int c) { const int st = (r >> 4) * 2 + (c >> 5), rr = r & 15, cc = c & 31, ob = rr * 64 + cc * 2; return st * 1024 + (ob ^ (((ob >> 9) & 1) << 5)); }
__host__ __device__ __forceinline__ void stage_rc(int b, int& R, int& C) { const int st = b / 1024, sb = b % 1024, swz = sb ^ (((sb >> 9) & 1) << 5); R = (st >> 1) * 16 + swz / 64; C = (st & 1) * 32 + (swz % 64) / 2; }
__host__ __device__ __forceinline__ int perm32(int rho) { const int n = rho >> 4, i = rho & 15; return 8 * (i >> 2) + 4 * n + (i & 3); }
struct Unit { int pm, pn, e, p0, nvalid, prow, sub; };
template <class Epi, class Sched, bool ALIGN_EPI = true>
__device__ __forceinline__ void gemm_phase(LAS unsigned char* lds, const Sched& S, const Epi& E, int wv) {
    const int tid = opaque_tid(wv), wid = __builtin_amdgcn_readfirstlane(tid >> 6), lane = tid & 63, wr = wid >> 2, wc = wid & 3, fr = lane & 15, fq = lane >> 4;
    const int nt = S.K / BK;
    int R0, C0, R1, C1; stage_rc(tid * 16, R0, C0); stage_rc(tid * 16 + 8192, R1, C1);
    const int Rb0 = Epi::PERM ? ((R0 & ~31) + perm32(R0 & 31)) : R0, Rb1 = Epi::PERM ? ((R1 & ~31) + perm32(R1 & 31)) : R1;
    const unsigned vB0 = (unsigned)(Rb0 * S.ldb + C0) * 2u, vB1 = (unsigned)(Rb1 * S.ldb + C1) * 2u;
    const size_t kstep = (size_t)(BK * 2);
    const size_t hstepB = (size_t)HALF * S.ldb * 2;
    const unsigned ldsw = (unsigned)wid * 1024u;
    const int aoff = lds_byte(wr * 64 + fr, fq * 8), boff = lds_byte(wc * 32 + fr, fq * 8);
#define PG8_SA(b, h) (((b) * 2 + (h)) * HTB)
#define PG8_SB(b, h) ((4 + (b) * 2 + (h)) * HTB)
#define PG8_STAGE2(bufoff, gbase, o0, o1) do { \
        __builtin_amdgcn_global_load_lds((const unsigned*)((const char*)(gbase) + (o0)), (LAS unsigned*)(lds + (bufoff) + ldsw), 16, 0, 0); \
        __builtin_amdgcn_global_load_lds((const unsigned*)((const char*)(gbase) + (o1)), (LAS unsigned*)(lds + (bufoff) + ldsw + 8192), 16, 0, 0); } while (0)
#define PG8_LDA(dst, b, h) do { _Pragma("unroll") for (int m = 0; m < 4; ++m) _Pragma("unroll") for (int k = 0; k < 2; ++k) dst[m][k] = *(const LAS bf16x8*)(lds + PG8_SA(b, h) + aoff + m * 2048 + k * 1024); } while (0)
#define PG8_LDB(dst, b, h) do { _Pragma("unroll") for (int n = 0; n < 2; ++n) _Pragma("unroll") for (int k = 0; k < 2; ++k) dst[n][k] = *(const LAS bf16x8*)(lds + PG8_SB(b, h) + boff + n * 2048 + k * 1024); } while (0)
#define PG8_MMA(ai, bj, At, Bt) do { __builtin_amdgcn_s_setprio(1); _Pragma("unroll") for (int m = 0; m < 4; ++m) _Pragma("unroll") for (int n = 0; n < 2; ++n) _Pragma("unroll") for (int k = 0; k < 2; ++k) \
        acc[ai][bj][m][n] = __builtin_amdgcn_mfma_f32_16x16x32_bf16(Bt[n][k], At[m][k], acc[ai][bj][m][n], 0, 0, 0); __builtin_amdgcn_s_setprio(0); } while (0)
#define PG8_WAIT_V(n) asm volatile("s_waitcnt vmcnt(" #n ")" ::: "memory")
#define PG8_WAIT_L(n) asm volatile("s_waitcnt lgkmcnt(" #n ")" ::: "memory")
#define PG8_BAR __builtin_amdgcn_s_barrier()
#define PG8_SCHED __builtin_amdgcn_sched_barrier(0)
    Unit cur, nxt; int ui = 0;
    if (!S.next(0, cur)) return;
    f32x4 acc[2][2][4][2];
#pragma unroll
    for (int a = 0; a < 2; ++a)
#pragma unroll
        for (int b = 0; b < 2; ++b)
#pragma unroll
            for (int m = 0; m < 4; ++m)
#pragma unroll
                for (int n = 0; n < 2; ++n) acc[a][b][m][n] = (f32x4){0.f, 0.f, 0.f, 0.f};
    bf16x8 At[4][2], B0[2][2], B1[2][2];
    const char* cA = S.a_base(cur); const char* cB = S.b_base(cur);
    unsigned c00 = S.a_off(cur, R0, C0), c01 = S.a_off(cur, R1, C1), c10 = S.a_off(cur, HALF + R0, C0), c11 = S.a_off(cur, HALF + R1, C1);
    PG8_STAGE2(PG8_SB(0, 0), cB, vB0, vB1); PG8_STAGE2(PG8_SB(0, 1), cB + hstepB, vB0, vB1); PG8_STAGE2(PG8_SA(0, 0), cA, c00, c01); PG8_STAGE2(PG8_SA(0, 1), cA, c10, c11);
    if (wr == 1) PG8_BAR;
    PG8_WAIT_V(2); PG8_BAR;
    PG8_STAGE2(PG8_SB(1, 0), cB + kstep, vB0, vB1); PG8_STAGE2(PG8_SA(1, 0), cA + kstep, c00, c01); PG8_STAGE2(PG8_SB(1, 1), cB + hstepB + kstep, vB0, vB1);
    PG8_WAIT_V(6); PG8_BAR;
    for (;;) {
        const bool has_next = S.next(ui + 1, nxt);
        const char* nA = has_next ? S.a_base(nxt) : cA; const char* nB = has_next ? S.b_base(nxt) : cB;
        unsigned n00 = c00, n01 = c01, n10 = c10, n11 = c11;
        if (has_next) { n00 = S.a_off(nxt, R0, C0); n01 = S.a_off(nxt, R1, C1); n10 = S.a_off(nxt, HALF + R0, C0); n11 = S.a_off(nxt, HALF + R1, C1); }
        for (int t = 0; t < nt; t += 2) {
            const bool last = (t == nt - 2);
            const char* a1 = cA + (size_t)(t + 1) * kstep;
            const char* a2 = last ? nA : cA + (size_t)(t + 2) * kstep; const char* b2 = last ? nB : cB + (size_t)(t + 2) * kstep;
            const char* a3 = a2 + kstep; const char* b3 = b2 + kstep;
            const unsigned s00 = last ? n00 : c00, s01 = last ? n01 : c01, s10 = last ? n10 : c10, s11 = last ? n11 : c11;
            PG8_LDB(B0, 0, 0); PG8_LDB(B1, 0, 1); PG8_SCHED; PG8_LDA(At, 0, 0); PG8_STAGE2(PG8_SA(1, 1), a1, c10, c11);
            PG8_WAIT_V(8); PG8_WAIT_L(0); PG8_BAR; PG8_MMA(0, 0, At, B0); PG8_MMA(0, 1, At, B1); PG8_BAR; PG8_SCHED;
            PG8_LDA(At, 0, 1); PG8_STAGE2(PG8_SB(0, 0), b2, vB0, vB1); PG8_STAGE2(PG8_SB(0, 1), b2 + hstepB, vB0, vB1); PG8_STAGE2(PG8_SA(0, 0), a2, s00, s01);
            PG8_WAIT_V(8); PG8_WAIT_L(0); PG8_BAR; PG8_MMA(1, 0, At, B0); PG8_MMA(1, 1, At, B1); PG8_BAR; PG8_SCHED;
            PG8_LDB(B0, 1, 0); PG8_LDB(B1, 1, 1); PG8_SCHED; PG8_LDA(At, 1, 0); PG8_STAGE2(PG8_SA(0, 1), a2, s10, s11);
            PG8_WAIT_V(8); PG8_WAIT_L(0); PG8_BAR; PG8_MMA(0, 0, At, B0); PG8_MMA(0, 1, At, B1); PG8_BAR; PG8_SCHED;
            PG8_LDA(At, 1, 1); PG8_STAGE2(PG8_SB(1, 0), b3, vB0, vB1); PG8_STAGE2(PG8_SB(1, 1), b3 + hstepB, vB0, vB1); PG8_STAGE2(PG8_SA(1, 0), a3, s00, s01);
            PG8_WAIT_V(8); PG8_WAIT_L(0); PG8_BAR; PG8_MMA(1, 0, At, B0); PG8_MMA(1, 1, At, B1); PG8_BAR; PG8_SCHED;
        }
        if constexpr (ALIGN_EPI) { if (wr == 0) PG8_BAR; }
        E(acc, cur, wr, wc, fr, fq);
        if (!has_next) break;
        if (!(Epi::ACCUM && cur.sub + 1 < S.nsub)) {
#pragma unroll
        for (int a = 0; a < 2; ++a)
#pragma unroll
            for (int b = 0; b < 2; ++b)
#pragma unroll
                for (int m = 0; m < 4; ++m)
#pragma unroll
                    for (int n = 0; n < 2; ++n) acc[a][b][m][n] = (f32x4){0.f, 0.f, 0.f, 0.f};
        }
        cur = nxt; cA = nA; cB = nB; c00 = n00; c01 = n01; c10 = n10; c11 = n11; ++ui;
        if constexpr (ALIGN_EPI) { if (wr == 1) PG8_BAR; }
    }
    PG8_WAIT_V(0);
    if constexpr (!ALIGN_EPI) { if (wr == 0) PG8_BAR; }
    PG8_BAR;
#undef PG8_SA
#undef PG8_SB
#undef PG8_STAGE2
#undef PG8_LDA
#undef PG8_LDB
#undef PG8_MMA
#undef PG8_WAIT_V
#undef PG8_WAIT_L
#undef PG8_BAR
#undef PG8_SCHED
}

struct DenseOrder {
    const char* A; const char* Bt; int lda, ldb, K; int nM, nN, nwg, G, c, nsub;
    __device__ void init(const void* A_, int lda_, const void* Bt_, int ldb_, int M, int N, int K_, int G_, int c_, int nsub_ = 1) { A = (const char*)A_; Bt = (const char*)Bt_; lda = lda_; ldb = ldb_; K = K_; nM = M / BM; nN = N / BM; nwg = nM * nN; G = G_; c = c_; nsub = nsub_; }
    __device__ bool next(int i, Unit& u) const {
        u.sub = i % nsub; i /= nsub;
        const long L = (long)i * G + c; if (L >= nwg) return false;
        int wgid = (int)L; { const int q = nwg / 8, r = nwg % 8, xcd = wgid % 8, off = wgid / 8; wgid = (xcd < r ? xcd * (q + 1) : r * (q + 1) + (xcd - r) * q) + off; }
        const int nig = 8 * nN, gid = wgid / nig, fm = gid * 8, gsz = (nM - fm) < 8 ? (nM - fm) : 8;
        u.pm = fm + ((wgid % nig) % gsz); u.pn = (wgid % nig) / gsz; u.e = 0; u.p0 = 0; u.nvalid = 256; u.prow = 0; return true;
    }
    __device__ __forceinline__ const char* a_base(const Unit& u) const { return A + (size_t)u.pm * BM * lda * 2 + (size_t)u.sub * K * 2; }
    __device__ __forceinline__ const char* b_base(const Unit& u) const { return Bt + (size_t)u.pn * BM * ldb * 2 + (size_t)u.sub * K * 2; }
    __device__ __forceinline__ unsigned a_off(const Unit&, int row, int col) const { return (unsigned)(row * lda + col) * 2u; }
};
struct GroupOrder {
    static constexpr int nsub = 1;
    const char* A; const char* Bt; size_t strideA, strideB; int lda, ldb, K; int nM, nN, nwg, G, c;
    __device__ void init(const void* A_, size_t sA, int lda_, const void* Bt_, size_t sB, int ldb_, int ngroups, int M, int N, int K_, int G_, int c_) {
        A = (const char*)A_; Bt = (const char*)Bt_; strideA = sA; strideB = sB; lda = lda_; ldb = ldb_; K = K_; nM = M / BM; nN = N / BM; nwg = ngroups * nM * nN; G = G_; c = c_; }
    __device__ bool next(int i, Unit& u) const {
        const long L = (long)i * G + c; if (L >= nwg) return false;
        const int per = nM * nN; u.e = (int)L / per; const int r = (int)L % per; u.pm = r / nN; u.pn = r % nN; u.p0 = 0; u.nvalid = 256; u.prow = 0; u.sub = 0; return true;
    }
    __device__ __forceinline__ const char* a_base(const Unit& u) const { return A + (size_t)u.e * strideA + (size_t)u.pm * BM * lda * 2; }
    __device__ __forceinline__ const char* b_base(const Unit& u) const { return Bt + (size_t)u.e * strideB + (size_t)u.pn * BM * ldb * 2; }
    __device__ __forceinline__ unsigned a_off(const Unit&, int row, int col) const { return (unsigned)(row * lda + col) * 2u; }
};
template <bool GATHER>
struct MoeOrder {
    static constexpr int nsub = 1;
    const char* A; const char* Bt; size_t strideB; int lda, ldb, K; int nN, G, c; const unsigned* cnt; const int* list;
    __device__ bool next(int i, Unit& u) const {
        const int uu = i * G + c; const int q = uu / nN; u.pn = uu % nN; int accp = 0; bool found = false;
        for (int e = 0; e < NE; ++e) { const int n = (int)ld_agent(cnt + e * CNT_STRIDE); const int np = (n + 255) >> 8;
            if (!found && q < accp + np) { u.e = e; u.p0 = (q - accp) * 256; u.nvalid = (n - u.p0) < 256 ? (n - u.p0) : 256; found = true; }
            accp += np; }
        u.pm = q; u.prow = q * 256; u.sub = 0; return found;
    }
    __device__ __forceinline__ const char* a_base(const Unit& u) const { return GATHER ? A : A + (size_t)u.prow * lda * 2; }
    __device__ __forceinline__ const char* b_base(const Unit& u) const { return Bt + (size_t)u.e * strideB + (size_t)u.pn * BM * ldb * 2; }
    __device__ __forceinline__ unsigned a_off(const Unit& u, int row, int col) const {
        if (GATHER) { int tok = 0; if (row < u.nvalid) tok = (int)ld_agent((const unsigned*)list + (size_t)u.e * CAP + u.p0 + row) >> 1; return (unsigned)(tok * lda + col) * 2u; }
        return (unsigned)(row * lda + col) * 2u;
    }
};
}

using pg8::Unit;
#define EPI_LOOP_AI_M _Pragma("unroll") for (int ai = 0; ai < 2; ++ai) _Pragma("unroll") for (int m = 0; m < 4; ++m)
__device__ __forceinline__ u32x4 pack8(const f32x4& a, const f32x4& b) { u32x4 w; w.x = cvt_pk_bf16(a[0], a[1]); w.y = cvt_pk_bf16(a[2], a[3]); w.z = cvt_pk_bf16(b[0], b[1]); w.w = cvt_pk_bf16(b[2], b[3]); return w; }
__device__ __forceinline__ void unpack8(const u32x4& w, f32x4& a, f32x4& b) { a = (f32x4){bflo(w.x), bfhi(w.x), bflo(w.y), bfhi(w.y)}; b = (f32x4){bflo(w.z), bfhi(w.z), bflo(w.w), bfhi(w.w)}; }

struct EpiInProj {
    static constexpr bool PERM = true, ACCUM = false;
    bf16_t* PA; bf16_t* UV; bf16_t* UG; bf16_t* GATES; const float* bgate;
    __device__ __forceinline__ void operator()(f32x4 (&acc)[2][2][4][2], const Unit& u, int wr, int wc, int fr, int fq) const {
        const int row0 = u.pm * 256 + wr * 64 + fr, colt = u.pn * 256 + wc * 32 + 8 * fq;
        EPI_LOOP_AI_M { const int r = row0 + ai * 128 + m * 16;
#pragma unroll
            for (int bj = 0; bj < 2; ++bj) { const int c = colt + bj * 128; f32x4 v0 = acc[ai][bj][m][0], v1 = acc[ai][bj][m][1]; bf16_t* dst;
                if (u.pn < 2) dst = PA + (size_t)r * 512 + c;
                else if (u.pn < 6) { dst = UV + (size_t)r * 1024 + (c - 512);
#pragma unroll
                    for (int j = 0; j < 4; ++j) { v0[j] = gelu_tanh_fast(v0[j]); v1[j] = gelu_tanh_fast(v1[j]); } }
                else if (u.pn < 8) { const int cs = c - 1536, g = cs >> 4, cc = cs & 15, n = r >> 5, s = r & 31; dst = UG + ((size_t)(g * NCH + n) * UGLD + s * 16 + cc); }
                else { const int cg = c - 2048; dst = GATES + (size_t)r * 3072 + cg; const f32x4 b0 = *(const f32x4*)(bgate + cg), b1 = *(const f32x4*)(bgate + cg + 4);
#pragma unroll
                    for (int j = 0; j < 4; ++j) { v0[j] = fast_sigmoid(v0[j] + b0[j]); v1[j] = fast_sigmoid(v1[j] + b1[j]); } }
                *(u32x4*)dst = pack8(v0, v1); } }
    }
};
struct EpiSst {
    static constexpr bool PERM = false, ACCUM = false;
    float* SST;
    __device__ __forceinline__ void operator()(f32x4 (&acc)[2][2][4][2], const Unit& u, int wr, int wc, int fr, int fq) const {
        const int row0 = u.pm * 256 + wr * 64 + fr, col0 = wc * 32 + 4 * fq;
        EPI_LOOP_AI_M { float* rowp = SST + ((size_t)u.e * NCH + row0 + ai * 128 + m * 16) * 128 + col0;
#pragma unroll
            for (int n = 0; n < 2; ++n) *(f32x4*)(rowp + n * 16) = acc[ai][0][m][n]; }
    }
};
struct EpiSsmOut {
    static constexpr bool PERM = true, ACCUM = false;
    bf16_t* YG;
    __device__ __forceinline__ void operator()(f32x4 (&acc)[2][2][4][2], const Unit& u, int wr, int wc, int fr, int fq) const {
        const int row0 = u.pm * 256 + wr * 64 + fr, colt = u.pn * 256 + wc * 32 + 8 * fq;
        EPI_LOOP_AI_M { const int n = row0 + ai * 128 + m * 16;
#pragma unroll
            for (int bj = 0; bj < 2; ++bj) { const int c = colt + bj * 128, t = c >> 4, cc = c & 15; f32x4 v0 = acc[ai][bj][m][0], v1 = acc[ai][bj][m][1];
#pragma unroll
                for (int j = 0; j < 4; ++j) { v0[j] = gelu_tanh_fast(v0[j]); v1[j] = gelu_tanh_fast(v1[j]); }
                *(u32x4*)(YG + (size_t)(n * QC + t) * 512 + u.e * 16 + cc) = pack8(v0, v1); } }
    }
};
struct EpiGlu {
    static constexpr bool PERM = true, ACCUM = false;
    const bf16_t* YG; bf16_t* YS; const float* gb;
    __device__ __forceinline__ void operator()(f32x4 (&acc)[2][2][4][2], const Unit& u, int wr, int wc, int fr, int fq) const {
        const int row0 = u.pm * 256 + wr * 64 + fr, colt = u.pn * 256 + wc * 32 + 8 * fq;
        EPI_LOOP_AI_M { const int r = row0 + ai * 128 + m * 16;
#pragma unroll
            for (int bj = 0; bj < 2; ++bj) { const int c = colt + bj * 128; f32x4 v0 = acc[ai][bj][m][0], v1 = acc[ai][bj][m][1], y0, y1;
                const f32x4 b0 = *(const f32x4*)(gb + c), b1 = *(const f32x4*)(gb + c + 4);
                unpack8(*(const u32x4*)(YG + (size_t)r * 512 + c), y0, y1);
#pragma unroll
                for (int j = 0; j < 4; ++j) { v0[j] = y0[j] * fast_sigmoid(v0[j] + b0[j]); v1[j] = y1[j] * fast_sigmoid(v1[j] + b1[j]); }
                *(u32x4*)(YS + (size_t)r * 1536 + 1024 + c) = pack8(v0, v1); }
            asm volatile("" ::: "memory"); }
    }
};
struct EpiBranch {
    static constexpr bool PERM = true, ACCUM = true;
    const bf16_t* GATES; bf16_t* MERGED;
    __device__ __forceinline__ void operator()(f32x4 (&acc)[2][2][4][2], const Unit& u, int wr, int wc, int fr, int fq) const {
        const int row0 = u.pm * 256 + wr * 64 + fr, colt = u.pn * 256 + wc * 32 + 8 * fq;
        if (u.sub < 2) {
            EPI_LOOP_AI_M { const int r = row0 + ai * 128 + m * 16;
#pragma unroll
                for (int bj = 0; bj < 2; ++bj) { const int c = colt + bj * 128; f32x4 a0, a1, b0, b1;
                    unpack8(*(const u32x4*)(GATES + (size_t)r * 3072 + u.sub * 1024 + c), a0, a1); unpack8(*(const u32x4*)(GATES + (size_t)r * 3072 + (u.sub + 1) * 1024 + c), b0, b1);
#pragma unroll
                    for (int j = 0; j < 4; ++j) { acc[ai][bj][m][0][j] *= a0[j] * __builtin_amdgcn_rcpf(b0[j]); acc[ai][bj][m][1][j] *= a1[j] * __builtin_amdgcn_rcpf(b1[j]); } }
                asm volatile("" ::: "memory"); }
        } else {
            EPI_LOOP_AI_M { const int r = row0 + ai * 128 + m * 16;
#pragma unroll
                for (int bj = 0; bj < 2; ++bj) { const int c = colt + bj * 128; f32x4 g0, g1;
                    unpack8(*(const u32x4*)(GATES + (size_t)r * 3072 + 2048 + c), g0, g1);
                    *(u32x4*)(MERGED + (size_t)r * 1024 + c) = pack8(acc[ai][bj][m][0] * g0, acc[ai][bj][m][1] * g1); }
                asm volatile("" ::: "memory"); }
        }
    }
};
struct EpiWout {
    static constexpr bool PERM = false, ACCUM = false;
    float* X;
    __device__ __forceinline__ void operator()(f32x4 (&acc)[2][2][4][2], const Unit& u, int wr, int wc, int fr, int fq) const {
        const int row0 = u.pm * 256 + wr * 64 + fr, col0 = u.pn * 256 + wc * 32 + 4 * fq;
        EPI_LOOP_AI_M { float* rowp = X + (size_t)(row0 + ai * 128 + m * 16) * 1024 + col0;
#pragma unroll
            for (int bj = 0; bj < 2; ++bj)
#pragma unroll
                for (int n = 0; n < 2; ++n) { f32x4* q = (f32x4*)(rowp + bj * 128 + n * 16); *q = *q + acc[ai][bj][m][n]; }
            asm volatile("" ::: "memory"); }
    }
};
struct EpiMoe1 {
    static constexpr bool PERM = true, ACCUM = false;
    bf16_t* ACT; const float* LW;
    __device__ __forceinline__ void operator()(f32x4 (&acc)[2][2][4][2], const Unit& u, int wr, int wc, int fr, int fq) const {
        const int rl0 = wr * 64 + fr, j0 = wc * 32 + 8 * fq;
        EPI_LOOP_AI_M { const int rl = rl0 + ai * 128 + m * 16; float w = 0.f;
            if (rl < u.nvalid) w = __uint_as_float(ld_agent((const unsigned*)LW + (size_t)u.e * CAP + u.p0 + rl));
            f32x4 g0 = acc[ai][0][m][0], g1 = acc[ai][0][m][1]; const f32x4 u0 = acc[ai][1][m][0], u1 = acc[ai][1][m][1];
#pragma unroll
            for (int j = 0; j < 4; ++j) { g0[j] = w * g0[j] * fast_sigmoid(g0[j]) * u0[j]; g1[j] = w * g1[j] * fast_sigmoid(g1[j]) * u1[j]; }
            *(u32x4*)(ACT + (size_t)(u.prow + rl) * 512 + u.pn * 128 + j0) = pack8(g0, g1); }
    }
};
struct EpiMoe2 {
    static constexpr bool PERM = true, ACCUM = false;
    bf16_t* YB; const int* LIST;
    __device__ __forceinline__ void operator()(f32x4 (&acc)[2][2][4][2], const Unit& u, int wr, int wc, int fr, int fq) const {
        const int rl0 = wr * 64 + fr, colt = u.pn * 256 + wc * 32 + 8 * fq;
        EPI_LOOP_AI_M { const int rl = rl0 + ai * 128 + m * 16;
            if (rl < u.nvalid) { const int idx = (int)ld_agent((const unsigned*)LIST + (size_t)u.e * CAP + u.p0 + rl); const int tok = idx >> 1, slot = idx & 1;
                bf16_t* rowp = YB + ((size_t)slot * T + tok) * 1024 + colt;
#pragma unroll
                for (int bj = 0; bj < 2; ++bj) *(u32x4*)(rowp + bj * 128) = pack8(acc[ai][bj][m][0], acc[ai][bj][m][1]); } }
    }
};

__device__ __forceinline__ void conv_tile_wave(const float* src, int ldsrc, bf16_t* dst, int ldd, LAS float* tile, int lane) {
    const int r = lane >> 4, c4 = (lane & 15) * 4;
    f32x4 v[16];
#pragma unroll
    for (int q = 0; q < 16; ++q) v[q] = __builtin_nontemporal_load((const f32x4*)(src + (size_t)(4 * q + r) * ldsrc + c4));
#pragma unroll
    for (int q = 0; q < 16; ++q) { LAS float* t = tile + (4 * q + r) * 65 + c4; t[0] = v[q][0]; t[1] = v[q][1]; t[2] = v[q][2]; t[3] = v[q][3]; }
    asm volatile("s_waitcnt lgkmcnt(0)" ::: "memory");
    const int jj = lane >> 3, kc = (lane & 7) * 8;
#pragma unroll
    for (int i2 = 0; i2 < 8; ++i2) { const int j = jj + 8 * i2; float x[8];
#pragma unroll
        for (int i = 0; i < 8; ++i) x[i] = tile[(kc + i) * 65 + j];
        u32x4 w; w.x = cvt_pk_bf16(x[0], x[1]); w.y = cvt_pk_bf16(x[2], x[3]); w.z = cvt_pk_bf16(x[4], x[5]); w.w = cvt_pk_bf16(x[6], x[7]);
        *(u32x4*)(dst + (size_t)j * ldd + kc) = w; }
    asm volatile("s_waitcnt lgkmcnt(0)" ::: "memory");
}
constexpr int CV_WIN = 1280, CV_WB = 256, CV_WOUT = 256, CV_GLU = 64, CV_GU = 8192, CV_DN = 4096;
constexpr int CV_TILES = CV_WIN + CV_WB + CV_WOUT + CV_GLU + CV_GU + CV_DN;
constexpr int CV_WEFF = 1024;
constexpr int CV_SGW = 128;
constexpr int CV_SSM = 128;
constexpr int CV_BLK = CV_SSM + CV_WEFF + CV_SGW;

__device__ __forceinline__ void ssm_precompute(const Params& p, const LayerPtrs& L, int g, int q, LAS unsigned char* lds, int wv);

__device__ __forceinline__ void st_conv(const Params& p, int l, int bid, int nb, LAS unsigned char* lds, int wv) {
    const LayerPtrs L = layer_ptrs(p, l);
    bf16_t* WIN = WSP(bf16_t, WS_WIN); bf16_t* WB = WSP(bf16_t, WS_WB); bf16_t* WOUT = WSP(bf16_t, WS_WOUT); bf16_t* GLU = WSP(bf16_t, WS_GLU);
    bf16_t* WGU = WSP(bf16_t, WS_WGU); bf16_t* WD = WSP(bf16_t, WS_WD); bf16_t* SGW = WSP(bf16_t, WS_SGW);
    for (int u = bid; u < CV_BLK; u += nb) {
        int i = u;
        if (i < CV_SSM) { ssm_precompute(p, L, i >> 2, i & 3, lds, wv); continue; }
        i -= CV_SSM;
        if (i < CV_WEFF) {
            const int o = i * 512 + opaque_tid(wv); const int kk = o >> 10, n = o & 1023, g = kk >> 7, c = kk & 127; float s = 0.f;
            const float* pw = L.pool_w + ((size_t)g * 128 + c) * 128; const float* sc = L.pool_scale + g * 128; const float* wb = L.w_branch + (size_t)(g * 128) * 1024 + n;
            for (int d = 0; d < 128; ++d) s += pw[d] * sc[d] * wb[(size_t)d * 1024];
            WB[(size_t)n * 1536 + kk] = f2bf(s); continue; }
        i -= CV_WEFF;
        { const int o = i * 512 + opaque_tid(wv); const int sidx = o & 127, t = (o >> 7) & 127; SGW[o] = (sidx <= t) ? f2bf(L.sgu_w[o]) : (bf16_t)0; }
    }
    __syncthreads();
    const int tid = opaque_tid(wv), lane = tid & 63; LAS float* tile = (LAS float*)lds + wv * (64 * 65);
    for (int u = bid * 8 + wv; u < CV_TILES; u += nb * 8) {
        int i = u; const float* src; int ldsrc; bf16_t* dst; int ldd;
        if (i < CV_WIN) { const int k0 = (i & 15) * 64, n0 = (i >> 4) * 64; src = L.w_in + (size_t)k0 * INC + n0; ldsrc = INC; dst = WIN + (size_t)n0 * 1024 + k0; ldd = 1024; }
        else if ((i -= CV_WIN) < CV_WB) { const int k = 1 + (i >> 7), sx = i & 127, k0 = (sx & 7) * 64, n0 = (sx >> 3) * 64; src = L.w_branch + (size_t)k * 512 * 1024 + (size_t)k0 * 1024 + n0; ldsrc = 1024; dst = WB + (size_t)n0 * 1536 + k * 512 + k0; ldd = 1536; }
        else if ((i -= CV_WB) < CV_WOUT) { const int k0 = (i & 15) * 64, n0 = (i >> 4) * 64; src = L.w_out + (size_t)k0 * 1024 + n0; ldsrc = 1024; dst = WOUT + (size_t)n0 * 1024 + k0; ldd = 1024; }
        else if ((i -= CV_WOUT) < CV_GLU) { const int k0 = (i & 7) * 64, n0 = (i >> 3) * 64; src = L.glu_w + (size_t)k0 * 512 + n0; ldsrc = 512; dst = GLU + (size_t)n0 * 512 + k0; ldd = 512; }
        else if ((i -= CV_GLU) < CV_GU) { const int e = i >> 8, sx = i & 255, isup = sx >> 7, ss = sx & 127, k0 = (ss & 15) * 64, n0 = (ss >> 4) * 64;
            src = (isup ? L.wu : L.wg) + (size_t)e * 1024 * 512 + (size_t)k0 * 512 + n0; ldsrc = 512;
            dst = WGU + (size_t)e * 1024 * 1024 + (size_t)(256 * (n0 >> 7) + (n0 & 127) + (isup ? 128 : 0)) * 1024 + k0; ldd = 1024; }
        else { i -= CV_GU; const int e = i >> 7, sx = i & 127, k0 = (sx & 7) * 64, n0 = (sx >> 3) * 64; src = L.wd + (size_t)e * 512 * 1024 + (size_t)k0 * 1024 + n0; ldsrc = 1024; dst = WD + (size_t)e * 1024 * 512 + (size_t)n0 * 512 + k0; ldd = 512; }
        conv_tile_wave(src, ldsrc, dst, ldd, tile, lane);
    }
    __syncthreads();
}

__device__ __forceinline__ void ssm_precompute(const Params& p, const LayerPtrs& L, int g, int q, LAS unsigned char* lds, int wv) {
    LAS f32x2* LP = (LAS f32x2*)lds; LAS f32x2* BB = (LAS f32x2*)(lds + 16896); LAS f32x2* CC = (LAS f32x2*)(lds + 16896 + 8192); LAS float* KM = (LAS float*)(lds + 16896 + 16384);
    bf16_t* ET = WSP(bf16_t, WS_ET) + (size_t)g * 256 * 512; bf16_t* TZF = WSP(bf16_t, WS_TZF) + (size_t)g * 512 * UGLD;
    const int tid = opaque_tid(wv); const float dt = expf(L.log_dt[g]);
    for (int o = tid; o < 33 * 64; o += NTHREADS) { const int j = o >> 6, pp = o & 63; const float lre = L.a_re[g * 64 + pp], lim = L.a_im[g * 64 + pp];
        const float er = expf((float)j * lre * dt); LP[o] = (f32x2){er * cosf((float)j * lim * dt), er * sinf((float)j * lim * dt)}; }
    for (int o = tid; o < 64 * 16; o += NTHREADS) { const int pp = o >> 4; const float lre = L.a_re[g * 64 + pp], lim = L.a_im[g * 64 + pp];
        const float er = expf(lre * dt), lbr = er * cosf(lim * dt), lbi = er * sinf(lim * dt); const float nr = lbr - 1.f, ni = lbi, den = lre * lre + lim * lim;
        const float cr = (nr * lre + ni * lim) / den, ci = (ni * lre - nr * lim) / den; const float br = L.b_re[(size_t)g * 1024 + o], bi = L.b_im[(size_t)g * 1024 + o];
        BB[o] = (f32x2){cr * br - ci * bi, cr * bi + ci * br}; }
    for (int o = tid; o < 16 * 64; o += NTHREADS) CC[o] = (f32x2){L.c_re[(size_t)g * 1024 + o], L.c_im[(size_t)g * 1024 + o]};
    __syncthreads();
    const int nj = 8 * q + 8;
    for (int o = tid; o < nj * 256; o += NTHREADS) { const int j = o >> 8, c = (o >> 4) & 15, c2 = o & 15; float s = 0.f;
        for (int pp = 0; pp < 64; ++pp) { const f32x2 cv = CC[c * 64 + pp], lp = LP[j * 64 + pp], bb = BB[pp * 16 + c2];
            const float mr = cv.x * lp.x - cv.y * lp.y, mi = cv.x * lp.y + cv.y * lp.x; s += mr * bb.x - mi * bb.y; }
        if (j == 0 && c == c2) s += L.ssm_d[g * 16 + c];
        KM[o] = s; }
    __syncthreads();
    for (int o = tid; o < 64 * 64; o += NTHREADS) { const int rr = 64 * q + (o >> 6), k8 = (o & 63) * 8; float v[8];
#pragma unroll
        for (int i = 0; i < 8; ++i) { float x = 0.f; if (rr < 128) { const int pp = rr >> 1, ri = rr & 1, k = k8 + i, s = k >> 4, c2 = k & 15; const f32x2 lp = LP[(31 - s) * 64 + pp], bb = BB[pp * 16 + c2];
                x = ri ? (lp.x * bb.y + lp.y * bb.x) : (lp.x * bb.x - lp.y * bb.y); } v[i] = x; }
        u32x4 w; w.x = cvt_pk_bf16(v[0], v[1]); w.y = cvt_pk_bf16(v[2], v[3]); w.z = cvt_pk_bf16(v[4], v[5]); w.w = cvt_pk_bf16(v[6], v[7]);
        *(u32x4*)(ET + (size_t)rr * 512 + k8) = w; }
    for (int o = tid; o < 128 * 80; o += NTHREADS) { const int row = 128 * q + o / 80, k8 = (o % 80) * 8, t = row >> 4, c = row & 15; float v[8];
#pragma unroll
        for (int i = 0; i < 8; ++i) { const int k = k8 + i; float x;
            if (k < 512) { const int s = k >> 4, c2 = k & 15; x = (s <= t) ? KM[(t - s) * 256 + c * 16 + c2] : 0.f; }
            else { const int kk = k - 512, pp = kk >> 1, ri = kk & 1; const f32x2 cv = CC[c * 64 + pp], lp = LP[(t + 1) * 64 + pp];
                x = ri ? -(cv.x * lp.y + cv.y * lp.x) : (cv.x * lp.x - cv.y * lp.y); }
            v[i] = x; }
        u32x4 w; w.x = cvt_pk_bf16(v[0], v[1]); w.y = cvt_pk_bf16(v[2], v[3]); w.z = cvt_pk_bf16(v[4], v[5]); w.w = cvt_pk_bf16(v[6], v[7]);
        *(u32x4*)(TZF + (size_t)row * UGLD + k8) = w; }
    __syncthreads();
}

template <bool ADD_YB, bool FINAL, bool WRITE_X, bool DUP = false>
__device__ __forceinline__ void st_prep(const Params& p, const float* Xin, const float* gain, int bid, int nb, int wv) {
    float* X = DUP ? WSP(float, WS_PA) : p.out; bf16_t* HB = DUP ? WSP(bf16_t, WS_SST) : WSP(bf16_t, WS_HB); const bf16_t* YB = WSP(bf16_t, WS_YB);
    const int tid = opaque_tid(wv); const int wave = tid >> 6, lane = tid & 63;
    for (int t = bid * 8 + wave; t < T; t += nb * 8) {
        f32x4 v[4]; float ss = 0.f;
#pragma unroll
        for (int i = 0; i < 4; ++i) { const int c = 4 * (lane + 64 * i); v[i] = *(const f32x4*)(Xin + (size_t)t * D + c);
            if (ADD_YB) { const u32x2 a = *(const u32x2*)(YB + (size_t)t * D + c), b = *(const u32x2*)(YB + ((size_t)T + t) * D + c);
                v[i][0] += bflo(a.x) + bflo(b.x); v[i][1] += bfhi(a.x) + bfhi(b.x); v[i][2] += bflo(a.y) + bflo(b.y); v[i][3] += bfhi(a.y) + bfhi(b.y); }
            ss += v[i][0] * v[i][0] + v[i][1] * v[i][1] + v[i][2] * v[i][2] + v[i][3] * v[i][3]; }
        ss = wave_sum(ss); const float r = rsqrtf(ss / (float)D + EPS);
#pragma unroll
        for (int i = 0; i < 4; ++i) { const int c = 4 * (lane + 64 * i); const f32x4 g = *(const f32x4*)(gain + c); const f32x4 h = v[i] * r * g;
            if (FINAL) *(f32x4*)(X + (size_t)t * D + c) = h;
            else { if (WRITE_X) *(f32x4*)(X + (size_t)t * D + c) = v[i]; u32x2 w; w.x = cvt_pk_bf16(h[0], h[1]); w.y = cvt_pk_bf16(h[2], h[3]); *(u32x2*)(HB + (size_t)t * D + c) = w; } }
    }
}

__device__ __forceinline__ void st_pool(const Params& p, int bid, int nb, int wv) {
    const bf16_t* PA = WSP(bf16_t, WS_PA); bf16_t* YS = WSP(bf16_t, WS_YS);
    const int tid = opaque_tid(wv);
    for (int idx = bid * NTHREADS + tid; idx < T * 64; idx += nb * NTHREADS) {
        const int t = idx >> 6, ch = (idx & 63) * 8, g = ch >> 7, w = 2 << g, pos = t & (SEQ - 1), cnt = (pos + 1 < w) ? pos + 1 : w;
        f32x4 s0 = {0.f, 0.f, 0.f, 0.f}, s1 = s0, x0, x1;
        unpack8(*(const u32x4*)(PA + (size_t)t * 512 + ch), x0, x1); s0 = x0; s1 = x1;
        for (int j = 1; j < cnt; ++j) { f32x4 a0, a1; unpack8(*(const u32x4*)(PA + (size_t)(t - j) * 512 + ch), a0, a1); s0 = s0 + a0; s1 = s1 + a1; }
        const float inv = 1.0f / (float)cnt;
        *(u32x4*)(YS + (size_t)t * 1536 + ch) = pack8(s0 * inv - x0, s1 * inv - x1);
    }
}

__device__ __forceinline__ void sgu_unit(const Params& p, const LayerPtrs& L, int unit, LAS unsigned char* lds, int wv) {
    const bf16_t* UV = WSP(bf16_t, WS_UV); bf16_t* YS = WSP(bf16_t, WS_YS); const bf16_t* SGW = WSP(bf16_t, WS_SGW);
    LAS bf16_t* VT = (LAS bf16_t*)lds; LAS float* MU = (LAS float*)(lds + 34816); LAS float* RS = MU + 128;
    const int cb = (unit >> 2) * 128, h = unit & 3; const int tid = opaque_tid(wv), wave = tid >> 6, lane = tid & 63;
    for (int i = 0; i < 16; ++i) { const int s = wave * 16 + i; f32x4 a0, a1; unpack8(*(const u32x4*)(UV + (size_t)(cb + s) * 1024 + 512 + lane * 8), a0, a1);
        float sm = (a0[0] + a0[1]) + (a0[2] + a0[3]) + (a1[0] + a1[1]) + (a1[2] + a1[3]); sm = wave_sum(sm); const float mu = sm * (1.0f / 512.0f);
        const f32x4 d0 = a0 - mu, d1 = a1 - mu; float q = d0[0] * d0[0] + d0[1] * d0[1] + d0[2] * d0[2] + d0[3] * d0[3] + d1[0] * d1[0] + d1[1] * d1[1] + d1[2] * d1[2] + d1[3] * d1[3];
        q = wave_sum(q); if (lane == 0) { MU[s] = mu; RS[s] = rsqrtf(q * (1.0f / 512.0f) + EPS); } }
    __syncthreads();
    { const int s = tid & 127, cq = tid >> 7; const float mu = MU[s], rs = RS[s];
#pragma unroll
        for (int i = 0; i < 4; ++i) { const int c8 = (cq * 4 + i) * 8; f32x4 a0, a1; unpack8(*(const u32x4*)(UV + (size_t)(cb + s) * 1024 + 512 + h * 128 + c8), a0, a1);
            const f32x4 g0 = *(const f32x4*)(L.ln_g + h * 128 + c8), g1 = *(const f32x4*)(L.ln_g + h * 128 + c8 + 4), b0 = *(const f32x4*)(L.ln_b + h * 128 + c8), b1 = *(const f32x4*)(L.ln_b + h * 128 + c8 + 4);
            a0 = (a0 - mu) * rs * g0 + b0; a1 = (a1 - mu) * rs * g1 + b1;
#pragma unroll
            for (int j = 0; j < 4; ++j) { VT[(c8 + j) * 136 + s] = f2bf(a0[j]); VT[(c8 + 4 + j) * 136 + s] = f2bf(a1[j]); } } }
    __syncthreads();
    const int fr = lane & 15, fq = lane >> 4;
    bf16x8 A[4];
#pragma unroll
    for (int ks = 0; ks < 4; ++ks) A[ks] = *(const bf16x8*)(SGW + ((size_t)h * 128 + wave * 16 + fr) * 128 + ks * 32 + fq * 8);
    f32x4 acc[8];
#pragma unroll
    for (int n = 0; n < 8; ++n) { acc[n] = (f32x4){0.f, 0.f, 0.f, 0.f};
#pragma unroll
        for (int ks = 0; ks < 4; ++ks) { const bf16x8 B = *(const LAS bf16x8*)(VT + (n * 16 + fr) * 136 + ks * 32 + fq * 8); acc[n] = __builtin_amdgcn_mfma_f32_16x16x32_bf16(A[ks], B, acc[n], 0, 0, 0); } }
#pragma unroll
    for (int n = 0; n < 8; ++n)
#pragma unroll
        for (int r = 0; r < 4; ++r) { const int tl = wave * 16 + 4 * fq + r, ch = h * 128 + n * 16 + fr; const float sv = acc[n][r] + L.sgu_b[h * 128 + tl];
            const float uu = bf2f(UV[(size_t)(cb + tl) * 1024 + ch]); YS[(size_t)(cb + tl) * 1536 + 512 + ch] = f2bf(uu * sv); }
    __syncthreads();
}

__device__ __forceinline__ void st_scan(const Params& p, const LayerPtrs& L, int bid, int nb, int wv) {
    const float* SST = WSP(float, WS_SST); bf16_t* UG = WSP(bf16_t, WS_UG);
    const int tid = opaque_tid(wv); const int wave = tid >> 6, lane = tid & 63; const int w = bid * 8 + wave;
    if (w >= 128) return;
    const int b = w >> 5, g = w & 31; const float dt = expf(L.log_dt[g]); const float lre = L.a_re[g * 64 + lane], lim = L.a_im[g * 64 + lane];
    const float er = expf((float)QC * lre * dt); const float qr = er * cosf((float)QC * lim * dt), qi = er * sinf((float)QC * lim * dt);
    float xr = 0.f, xi = 0.f;
    for (int k0 = 0; k0 < SEQ / QC; k0 += 16) { const int n0 = b * (SEQ / QC) + k0; f32x2 sv[16];
#pragma unroll
        for (int j = 0; j < 16; ++j) sv[j] = *(const f32x2*)(SST + ((size_t)g * NCH + n0 + j) * 128 + 2 * lane);
#pragma unroll
        for (int j = 0; j < 16; ++j) { *(unsigned*)(UG + ((size_t)g * NCH + n0 + j) * UGLD + 512 + 2 * lane) = cvt_pk_bf16(xr, xi);
            const float nr = qr * xr - qi * xi + sv[j].x, ni = qr * xi + qi * xr + sv[j].y; xr = nr; xi = ni; } }
}

template <bool DUP>
__device__ __forceinline__ void st_route(const Params& p, const LayerPtrs& L, int l, int bid, int nb, LAS unsigned char* lds, int wv) {
    LAS float* RW = (LAS float*)lds; const float* X = p.out; bf16_t* HB = DUP ? WSP(bf16_t, WS_SST) : WSP(bf16_t, WS_HB);
    unsigned* cnt = WSP(unsigned, WS_CTL) + CW_CNT + (l * 32 + (DUP ? 64 : 0)) * CNT_STRIDE; int* LIST = DUP ? WSP(int, WS_PA) : WSP(int, WS_LIST); float* LW = DUP ? WSP(float, WS_PA + 4 * MiB) : WSP(float, WS_LW);
    const int tid = opaque_tid(wv), lane = tid & 63;
#pragma unroll 4
    for (int f = tid; f < 8192; f += NTHREADS) { const int k = f >> 3, n4 = (f & 7) * 4; const f32x4 w = *(const f32x4*)(L.rew + (size_t)f * 4); const float g = L.norm_ffn_g[k];
        LAS float* d = RW + k * 36 + 4 + n4; d[0] = w[0] * g; d[1] = w[1] * g; d[2] = w[2] * g; d[3] = w[3] * g; }
#pragma unroll 2
    for (int f = tid; f < 1024; f += NTHREADS) { const f32x4 w = *(const f32x4*)(L.rgw + (size_t)f * 4); const float g = L.norm_ffn_g[f];
        LAS float* d = RW + f * 36; d[0] = w[0] * g; d[1] = w[1] * g; d[2] = w[2] * g; d[3] = w[3] * g; }
    __syncthreads();
    LAS float* EL = (LAS float*)(lds + 147456 + wv * 1024); LAS float* SS = EL + 128;
    if (wv >= 4) {
        for (int grp = (wv - 4) * nb + bid; grp < T / 16; grp += 4 * nb) {
            for (int i = 0; i < 16; ++i) { const int t = grp * 16 + i; f32x4 v[4]; float ss = 0.f;
#pragma unroll
                for (int c4 = 0; c4 < 4; ++c4) { const int c = 4 * (lane + 64 * c4); v[c4] = *(const f32x4*)(X + (size_t)t * D + c); ss += v[c4][0] * v[c4][0] + v[c4][1] * v[c4][1] + v[c4][2] * v[c4][2] + v[c4][3] * v[c4][3]; }
                ss = wave_sum(ss); const float r = rsqrtf(ss * (1.0f / (float)D) + EPS);
#pragma unroll
                for (int c4 = 0; c4 < 4; ++c4) { const int c = 4 * (lane + 64 * c4); const f32x4 g = *(const f32x4*)(L.norm_ffn_g + c); const f32x4 h = v[c4] * r * g;
                    u32x2 w; w.x = cvt_pk_bf16(h[0], h[1]); w.y = cvt_pk_bf16(h[2], h[3]); *(u32x2*)(HB + (size_t)t * D + c) = w; } } }
    } else
    for (int grp = wv * nb + bid; grp < T / 16; grp += 4 * nb) {
        int ln = lane; asm volatile("" : "+v"(ln));
        const int tl = ln & 15, q = ln >> 4;
        const int t0 = grp * 16; const float* xr = X + (size_t)(t0 + tl) * D + 4 * q;
        f32x4 acc0 = {0.f, 0.f, 0.f, 0.f}, acc1 = acc0, acc2 = acc0; float ss = 0.f;
        f32x4 xa[16];
#pragma unroll
        for (int i = 0; i < 16; ++i) xa[i] = *(const f32x4*)(xr + i * 16);
        const int tl2 = 32 + (tl & 3);
#pragma unroll 1
        for (int kc = 0; kc < 4; ++kc) { const float* xn = xr + (kc < 3 ? kc + 1 : 3) * 256; const LAS float* wk = RW + (kc * 256 + 4 * q) * 36;
#pragma unroll
            for (int i = 0; i < 16; ++i) { const f32x4 xv = xa[i];
                xa[i] = *(const f32x4*)(xn + i * 16);
                ss += xv[0] * xv[0] + xv[1] * xv[1] + xv[2] * xv[2] + xv[3] * xv[3];
#pragma unroll
                for (int j = 0; j < 4; ++j) { const LAS float* wrow = wk + (i * 16 + j) * 36;
                    acc0 = __builtin_amdgcn_mfma_f32_16x16x4f32(xv[j], wrow[tl], acc0, 0, 0, 0);
                    acc1 = __builtin_amdgcn_mfma_f32_16x16x4f32(xv[j], wrow[tl + 16], acc1, 0, 0, 0);
                    acc2 = __builtin_amdgcn_mfma_f32_16x16x4f32(xv[j], wrow[tl2], acc2, 0, 0, 0); } } }
        SS[lane] = ss; asm volatile("s_waitcnt lgkmcnt(0)" ::: "memory");
        float rs[4];
#pragma unroll
        for (int r = 0; r < 4; ++r) { const int tok = 4 * q + r; rs[r] = rsqrtf(((SS[tok] + SS[tok + 16]) + (SS[tok + 32] + SS[tok + 48])) * (1.0f / (float)D) + EPS); }
        asm volatile("s_waitcnt lgkmcnt(0)" ::: "memory");
        const float bias0 = (tl < 4) ? L.rgb[tl] : L.reb[tl - 4], bias1 = L.reb[tl + 12], bias2 = (tl < 4) ? L.reb[tl + 28] : 0.f;
        float v0[4], v1[4], v2[4];
#pragma unroll
        for (int r = 0; r < 4; ++r) { v0[r] = acc0[r] * rs[r] + bias0; v1[r] = acc1[r] * rs[r] + bias1; v2[r] = acc2[r] * rs[r] + bias2; }
        LAS float* GL = SS;
        if (tl < 4) {
#pragma unroll
            for (int r = 0; r < 4; ++r) GL[(4 * q + r) * 4 + tl] = v0[r]; }
        asm volatile("s_waitcnt lgkmcnt(0)" ::: "memory");
#pragma unroll
        for (int r = 0; r < 4; ++r) { const int tok = 4 * q + r; const f32x4 g4 = *(const LAS f32x4*)(GL + tok * 4);
            int gi = 0; float gm = g4[0]; if (g4[1] > gm) { gm = g4[1]; gi = 1; } if (g4[2] > gm) { gm = g4[2]; gi = 2; } if (g4[3] > gm) { gm = g4[3]; gi = 3; }
            const int lo = 4 + 8 * gi; int j;
            j = tl - lo; if (j >= 0 && j < 8) EL[tok * 8 + j] = v0[r];
            j = tl + 16 - lo; if (j >= 0 && j < 8) EL[tok * 8 + j] = v1[r];
            j = tl + 32 - lo; if (j >= 0 && j < 8 && tl < 4) EL[tok * 8 + j] = v2[r]; }
        asm volatile("s_waitcnt lgkmcnt(0)" ::: "memory");
        if (lane < 32) { const int tok = lane & 15, slot = lane >> 4; const f32x4 g4 = *(const LAS f32x4*)(GL + tok * 4);
            int gi = 0; float gm = g4[0]; if (g4[1] > gm) { gm = g4[1]; gi = 1; } if (g4[2] > gm) { gm = g4[2]; gi = 2; } if (g4[3] > gm) { gm = g4[3]; gi = 3; }
            const float gval = 1.0f / (expf(g4[0] - gm) + expf(g4[1] - gm) + expf(g4[2] - gm) + expf(g4[3] - gm));
            const f32x4 ea = *(const LAS f32x4*)(EL + tok * 8), eb = *(const LAS f32x4*)(EL + tok * 8 + 4);
            float el[8] = {ea[0], ea[1], ea[2], ea[3], eb[0], eb[1], eb[2], eb[3]};
            int i0 = 0; float e0 = el[0];
#pragma unroll
            for (int j = 1; j < 8; ++j) if (el[j] > e0) { e0 = el[j]; i0 = j; }
            int i1 = -1; float e1 = -INFINITY;
#pragma unroll
            for (int j = 0; j < 8; ++j) if (j != i0 && el[j] > e1) { e1 = el[j]; i1 = j; }
            const float ex = expf(e1 - e0); const float w0 = gval / (1.f + ex), w1 = gval * ex / (1.f + ex);
            const int e = gi * 8 + (slot == 0 ? i0 : i1); const unsigned pos = atomicAdd(cnt + e * CNT_STRIDE, 1u);
            LIST[(size_t)e * CAP + pos] = (t0 + tok) * 2 + slot; LW[(size_t)e * CAP + pos] = slot == 0 ? w0 : w1; }
        asm volatile("s_waitcnt lgkmcnt(0)" ::: "memory");
    }
    __syncthreads();
}

namespace tw {
__device__ __forceinline__ float dot_bf16(const bf16_t* a, const bf16_t* b, int K) { float s = 0.f;
    for (int k = 0; k < K; k += 8) { f32x4 a0, a1, b0, b1; unpack8(*(const u32x4*)(a + k), a0, a1); unpack8(*(const u32x4*)(b + k), b0, b1);
        s += a0[0] * b0[0] + a0[1] * b0[1] + a0[2] * b0[2] + a0[3] * b0[3] + a1[0] * b1[0] + a1[1] * b1[1] + a1[2] * b1[2] + a1[3] * b1[3]; } return s; }
__global__ void __launch_bounds__(256) inproj(Params p, int l) {
    const LayerPtrs L = layer_ptrs(p, l); const int t = blockIdx.y, c = blockIdx.x * 256 + threadIdx.x;
    const float a = dot_bf16(WSP(bf16_t, WS_HB) + (size_t)t * 1024, WSP(bf16_t, WS_WIN) + (size_t)c * 1024, 1024);
    if (c < 512) WSP(bf16_t, WS_PA)[(size_t)t * 512 + c] = f2bf(a);
    else if (c < 1536) WSP(bf16_t, WS_UV)[(size_t)t * 1024 + c - 512] = f2bf(gelu_tanh_ref(a));
    else if (c < 2048) { const int cs = c - 1536, g = cs >> 4, cc = cs & 15, n = t >> 5, s = t & 31; WSP(bf16_t, WS_UG)[((size_t)g * NCH + n) * UGLD + s * 16 + cc] = f2bf(a); }
    else WSP(bf16_t, WS_GATES)[(size_t)t * 3072 + c - 2048] = f2bf(1.0f / (1.0f + expf(-(a + L.b_gate[c - 2048]))));
}
__global__ void __launch_bounds__(256) sgu_stats(Params p) {
    __shared__ float sh[8]; const int t = blockIdx.x; const bf16_t* UV = WSP(bf16_t, WS_UV); float* ST = WSP(float, WS_MERGED);
    const float a = bf2f(UV[(size_t)t * 1024 + 512 + threadIdx.x]), b = bf2f(UV[(size_t)t * 1024 + 768 + threadIdx.x]);
    float s = a + b; for (int o = 32; o >= 1; o >>= 1) s += __shfl_xor(s, o); __syncthreads(); if ((threadIdx.x & 63) == 0) sh[threadIdx.x >> 6] = s; __syncthreads(); const float mu = (sh[0] + sh[1] + sh[2] + sh[3]) / 512.f;
    float q = (a - mu) * (a - mu) + (b - mu) * (b - mu); for (int o = 32; o >= 1; o >>= 1) q += __shfl_xor(q, o); __syncthreads(); if ((threadIdx.x & 63) == 0) sh[threadIdx.x >> 6] = q; __syncthreads();
    if (threadIdx.x == 0) { ST[2 * t] = mu; ST[2 * t + 1] = rsqrtf((sh[0] + sh[1] + sh[2] + sh[3]) / 512.f + EPS); }
}
__global__ void __launch_bounds__(256) sgu_mix(Params p, int l) {
    const LayerPtrs L = layer_ptrs(p, l); const bf16_t* UV = WSP(bf16_t, WS_UV); const float* ST = WSP(float, WS_MERGED); bf16_t* YS = WSP(bf16_t, WS_YS);
    const int idx = blockIdx.x * 256 + threadIdx.x; const int t = idx >> 9, ch = idx & 511, h = ch >> 7, tl = t & 127, cb = t - tl; float s = 0.f;
    for (int sp = 0; sp <= tl; ++sp) { const float v = (bf2f(UV[(size_t)(cb + sp) * 1024 + 512 + ch]) - ST[2 * (cb + sp)]) * ST[2 * (cb + sp) + 1] * L.ln_g[ch] + L.ln_b[ch];
        s += L.sgu_w[((size_t)h * 128 + tl) * 128 + sp] * v; }
    s += L.sgu_b[h * 128 + tl];
    YS[(size_t)t * 1536 + 512 + ch] = f2bf(bf2f(UV[(size_t)t * 1024 + ch]) * s);
}
__global__ void __launch_bounds__(64) ssm(Params p, int l) {
    const LayerPtrs L = layer_ptrs(p, l); const bf16_t* UG = WSP(bf16_t, WS_UG); bf16_t* YG = WSP(bf16_t, WS_YG);
    const int b = blockIdx.x >> 5, g = blockIdx.x & 31, pp = threadIdx.x;
    const float lre = L.a_re[g * 64 + pp], lim = L.a_im[g * 64 + pp], dt = expf(L.log_dt[g]);
    const float er = expf(lre * dt); const float lbr = er * cosf(lim * dt), lbi = er * sinf(lim * dt);
    const float nr = lbr - 1.f, ni = lbi, den = lre * lre + lim * lim; const float cr = (nr * lre + ni * lim) / den, ci = (ni * lre - nr * lim) / den;
    float bbr[16], bbi[16], ccr[16], cci[16];
#pragma unroll
    for (int c = 0; c < 16; ++c) { const float br = L.b_re[(g * 64 + pp) * 16 + c], bi = L.b_im[(g * 64 + pp) * 16 + c]; bbr[c] = cr * br - ci * bi; bbi[c] = cr * bi + ci * br;
        ccr[c] = L.c_re[(g * 16 + c) * 64 + pp]; cci[c] = L.c_im[(g * 16 + c) * 64 + pp]; }
    const float dsk = L.ssm_d[g * 16 + (pp & 15)]; float xr = 0.f, xi = 0.f;
    for (int t = 0; t < SEQ; ++t) { const int tok = b * SEQ + t, n = tok >> 5, s = tok & 31; const bf16_t* row = UG + ((size_t)g * NCH + n) * UGLD + s * 16;
        float u[16];
#pragma unroll
        for (int c = 0; c < 16; ++c) u[c] = bf2f(row[c]);
        float bur = 0.f, bui = 0.f;
#pragma unroll
        for (int c = 0; c < 16; ++c) { bur += bbr[c] * u[c]; bui += bbi[c] * u[c]; }
        const float nxr = lbr * xr - lbi * xi + bur, nxi = lbr * xi + lbi * xr + bui; xr = nxr; xi = nxi; float yout = 0.f;
#pragma unroll
        for (int c = 0; c < 16; ++c) { float v = xr * ccr[c] - xi * cci[c]; for (int o = 32; o >= 1; o >>= 1) v += __shfl_xor(v, o); if (pp == c) yout = v + dsk * u[c]; }
        if (pp < 16) YG[(size_t)tok * 512 + g * 16 + pp] = f2bf(gelu_tanh_ref(yout)); }
}
__global__ void __launch_bounds__(256) glu(Params p, int l) {
    const LayerPtrs L = layer_ptrs(p, l); const int t = blockIdx.y, c = blockIdx.x * 256 + threadIdx.x; const bf16_t* YG = WSP(bf16_t, WS_YG);
    const float z = dot_bf16(YG + (size_t)t * 512, WSP(bf16_t, WS_GLU) + (size_t)c * 512, 512) + L.glu_b[c];
    WSP(bf16_t, WS_YS)[(size_t)t * 1536 + 1024 + c] = f2bf(bf2f(YG[(size_t)t * 512 + c]) / (1.0f + expf(-z)));
}
__global__ void __launch_bounds__(256) branch(Params p) {
    const int t = blockIdx.y, c = blockIdx.x * 256 + threadIdx.x; const bf16_t* YS = WSP(bf16_t, WS_YS) + (size_t)t * 1536; const bf16_t* WB = WSP(bf16_t, WS_WB) + (size_t)c * 1536; const bf16_t* G = WSP(bf16_t, WS_GATES) + (size_t)t * 3072;
    float s = 0.f;
    for (int k = 0; k < 3; ++k) s += bf2f(G[k * 1024 + c]) * dot_bf16(YS + k * 512, WB + k * 512, 512);
    WSP(bf16_t, WS_MERGED)[(size_t)t * 1024 + c] = f2bf(s);
}
__global__ void __launch_bounds__(256) wout(Params p) {
    const int t = blockIdx.y, c = blockIdx.x * 256 + threadIdx.x;
    p.out[(size_t)t * 1024 + c] += dot_bf16(WSP(bf16_t, WS_MERGED) + (size_t)t * 1024, WSP(bf16_t, WS_WOUT) + (size_t)c * 1024, 1024);
}
__global__ void __launch_bounds__(256) moe(Params p, int l) {
    __shared__ float act[512];
    const int e = blockIdx.y, pos = blockIdx.x; const unsigned n = WSP(unsigned, WS_CTL)[CW_CNT + (l * 32 + e) * CNT_STRIDE]; if ((unsigned)pos >= n) return;
    const int idx = WSP(int, WS_LIST)[(size_t)e * CAP + pos]; const float w = WSP(float, WS_LW)[(size_t)e * CAP + pos]; const int tok = idx >> 1, slot = idx & 1;
    const bf16_t* h = WSP(bf16_t, WS_HB) + (size_t)tok * 1024; const bf16_t* WGU = WSP(bf16_t, WS_WGU) + (size_t)e * 1024 * 1024; const bf16_t* WD = WSP(bf16_t, WS_WD) + (size_t)e * 1024 * 512;
    for (int j = threadIdx.x; j < 512; j += 256) { const int pn = j >> 7, jj = j & 127; const float g = dot_bf16(h, WGU + (size_t)(256 * pn + jj) * 1024, 1024), u = dot_bf16(h, WGU + (size_t)(256 * pn + 128 + jj) * 1024, 1024);
        act[j] = bf2f(f2bf(w * (g / (1.0f + expf(-g))) * u)); }
    __syncthreads();
    for (int d = threadIdx.x; d < 1024; d += 256) { float s = 0.f; const bf16_t* wr = WD + (size_t)d * 512; for (int k = 0; k < 512; ++k) s += act[k] * bf2f(wr[k]);
        WSP(bf16_t, WS_YB)[((size_t)slot * T + tok) * 1024 + d] = f2bf(s); }
}
}

enum { ST_CONV = 0, ST_PREP, ST_INPROJ, ST_MIXA, ST_SCAN, ST_SSMOUT, ST_GLU, ST_BRANCH, ST_WOUT, ST_ROUTE, ST_MOE1, ST_MOE2, ST_FINAL, ST_POOL, ST_SGU, ST_SST };

template <int STAGE, bool DUP = false>
__device__ __forceinline__ void run_stage(const Params& p_arg, int l, int bid, int nb, LAS unsigned char* lds, int wv) {
    asm volatile("" : "+s"(l));
    Params p;
#if defined(__HIP_DEVICE_COMPILE__)
    typedef const Params __attribute__((address_space(4))) KParams;
    const KParams* kp = (const KParams*)__builtin_amdgcn_kernarg_segment_ptr(); asm volatile("" : "+s"(kp));
#pragma unroll
    for (int i = 0; i < 31; ++i) p.in[i] = kp->in[i];
    p.out = kp->out; p.ws = kp->ws; (void)p_arg;
#else
    p = p_arg;
#endif
    const LayerPtrs L = layer_ptrs(p, l);
    if constexpr (STAGE == ST_CONV) st_conv(p, l, bid, nb, lds, wv);
    if constexpr (STAGE == ST_PREP) { if (l == 0) st_prep<false, false, true, DUP>(p, p.in[0], L.norm_mix_g, bid, nb, wv); else st_prep<true, false, true, DUP>(p, p.out, L.norm_mix_g, bid, nb, wv); }
    if constexpr (STAGE == ST_FINAL) st_prep<true, true, false, DUP>(p, p.out, p.in[30], bid, nb, wv);
    if constexpr (STAGE == ST_INPROJ) { pg8::DenseOrder S; S.init(WSP(bf16_t, WS_HB), 1024, WSP(bf16_t, WS_WIN), 1024, T, INC, 1024, nb, bid);
        EpiInProj E{WSP(bf16_t, WS_PA), WSP(bf16_t, WS_UV), WSP(bf16_t, WS_UG), WSP(bf16_t, WS_GATES), L.b_gate}; pg8::gemm_phase(lds, S, E, wv); }
    if constexpr (STAGE == ST_SST) { pg8::GroupOrder S; S.init(WSP(bf16_t, WS_UG), (size_t)NCH * UGLD * 2, UGLD, WSP(bf16_t, WS_ET), (size_t)256 * 512 * 2, 512, 32, NCH, 256, 512, nb, bid);
        EpiSst E{WSP(float, WS_SST)}; pg8::gemm_phase(lds, S, E, wv); }
    if constexpr (STAGE == ST_POOL) st_pool(p, bid, nb, wv);
    if constexpr (STAGE == ST_SGU) { for (int u = bid; u < 512; u += nb) sgu_unit(p, L, u, lds, wv); }
    if constexpr (STAGE == ST_SCAN) st_scan(p, L, bid, nb, wv);
    if constexpr (STAGE == ST_SSMOUT) { pg8::GroupOrder S; S.init(WSP(bf16_t, WS_UG), (size_t)NCH * UGLD * 2, UGLD, WSP(bf16_t, WS_TZF), (size_t)512 * UGLD * 2, UGLD, 32, NCH, 512, UGLD, nb, bid);
        EpiSsmOut E{WSP(bf16_t, WS_YG)}; pg8::gemm_phase(lds, S, E, wv); }
    if constexpr (STAGE == ST_GLU) { pg8::DenseOrder S; S.init(WSP(bf16_t, WS_YG), 512, WSP(bf16_t, WS_GLU), 512, T, 512, 512, nb, bid);
        EpiGlu E{WSP(bf16_t, WS_YG), WSP(bf16_t, WS_YS), L.glu_b}; pg8::gemm_phase(lds, S, E, wv); }
    if constexpr (STAGE == ST_BRANCH) { pg8::DenseOrder S; S.init(WSP(bf16_t, WS_YS), 1536, WSP(bf16_t, WS_WB), 1536, T, 1024, 512, nb, bid, 3);
        EpiBranch E{WSP(bf16_t, WS_GATES), WSP(bf16_t, WS_MERGED)}; pg8::gemm_phase(lds, S, E, wv); }
    if constexpr (STAGE == ST_WOUT) { pg8::DenseOrder S; S.init(WSP(bf16_t, WS_MERGED), 1024, WSP(bf16_t, WS_WOUT), 1024, T, 1024, 1024, nb, bid);
        EpiWout E{DUP ? WSP(float, WS_PA) : p.out}; pg8::gemm_phase(lds, S, E, wv); }
    if constexpr (STAGE == ST_ROUTE) st_route<DUP>(p, L, l, bid, nb, lds, wv);
    if constexpr (STAGE == ST_MOE1) { pg8::MoeOrder<true> S{(const char*)WSP(bf16_t, WS_HB), (const char*)WSP(bf16_t, WS_WGU), (size_t)1024 * 1024 * 2, 1024, 1024, 1024, 4, nb, bid, WSP(unsigned, WS_CTL) + CW_CNT + l * 32 * CNT_STRIDE, WSP(int, WS_LIST)};
        EpiMoe1 E{WSP(bf16_t, WS_ACT), WSP(float, WS_LW)}; pg8::gemm_phase(lds, S, E, wv); }
    if constexpr (STAGE == ST_MOE2) { pg8::MoeOrder<false> S{(const char*)WSP(bf16_t, WS_ACT), (const char*)WSP(bf16_t, WS_WD), (size_t)1024 * 512 * 2, 512, 512, 512, 4, nb, bid, WSP(unsigned, WS_CTL) + CW_CNT + l * 32 * CNT_STRIDE, WSP(int, WS_LIST)};
        EpiMoe2 E{WSP(bf16_t, WS_YB), WSP(int, WS_LIST)}; pg8::gemm_phase(lds, S, E, wv); }
}

template <int STAGE>
__global__ void __launch_bounds__(NTHREADS, 2) k_stage(Params p, int l) {
    extern __shared__ __attribute__((aligned(16))) unsigned char lds_raw[];
    run_stage<STAGE>(p, l, (int)blockIdx.x, (int)gridDim.x, (LAS unsigned char*)lds_raw, __builtin_amdgcn_readfirstlane((int)threadIdx.x >> 6));
}


__global__ void __launch_bounds__(NTHREADS, 2) k_mega(Params p) {
    extern __shared__ __attribute__((aligned(16))) unsigned char lds_raw[];
    LAS unsigned char* lds = (LAS unsigned char*)lds_raw;
    volatile LAS unsigned* xbw = (volatile LAS unsigned*)(lds + LDS_BYTES - 16);
    if (threadIdx.x < 4) xbw[threadIdx.x] = 0u;
    const int bid = (int)blockIdx.x, nb = (int)gridDim.x, wv = __builtin_amdgcn_readfirstlane((int)threadIdx.x >> 6);
    __syncthreads();
    XcdBarrier bar = xcd_barrier_post(WSP(unsigned, WS_CTL) + CW_BAR, xbw, wv);
#define RUN_(ST, l) do { run_stage<ST>(p, l, bid, nb, lds, wv); if ((DBL_MASK >> ST) & 1u) run_stage<ST, true>(p, l, bid, nb, lds, wv); } while (0)
#define MK_LAYER(l) do { \
        RUN_(ST_CONV, l); RUN_(ST_PREP, l); xcd_barrier(bar); \
        RUN_(ST_INPROJ, l); xcd_barrier(bar); \
        RUN_(ST_SST, l); RUN_(ST_POOL, l); RUN_(ST_SGU, l); xcd_barrier(bar); \
        RUN_(ST_SCAN, l); xcd_barrier(bar); \
        RUN_(ST_SSMOUT, l); xcd_barrier(bar); \
        RUN_(ST_GLU, l); xcd_barrier(bar); \
        RUN_(ST_BRANCH, l); xcd_barrier(bar); \
        RUN_(ST_WOUT, l); xcd_barrier(bar); \
        RUN_(ST_ROUTE, l); xcd_barrier(bar); \
        RUN_(ST_MOE1, l); xcd_barrier(bar); \
        RUN_(ST_MOE2, l); xcd_barrier(bar); \
    } while (0)
    MK_LAYER(0);
    MK_LAYER(1);
#undef MK_LAYER
    if ((DBL_MASK >> ST_FINAL) & 1u) run_stage<ST_FINAL, true>(p, 0, bid, nb, lds, wv);
    run_stage<ST_FINAL>(p, 0, bid, nb, lds, wv);
}

template <int STAGE> static void launch_stage(const Params& p, int l, int grid, hipStream_t stream) {
    static bool attr = false;
    if (!attr) { (void)hipFuncSetAttribute((const void*)k_stage<STAGE>, hipFuncAttributeMaxDynamicSharedMemorySize, LDS_BYTES); attr = true; }
    hipLaunchKernelGGL(k_stage<STAGE>, dim3(grid), dim3(NTHREADS), LDS_BYTES, stream, p, l);
}
#define FAST(s) ((FAST_MASK >> (s)) & 1u)

extern "C" void kernel_launch(void* const* d_in, const int* in_sizes, int n_in, void* d_out, int out_size, void* d_ws, size_t ws_size, hipStream_t stream) {
    if (n_in != 31 || out_size != T * D || ws_size < WS_END) { fprintf(stderr, "kernel_launch: unexpected shapes (n_in %d out %d ws %zu need %zu)\n", n_in, out_size, ws_size, (size_t)WS_END); return; }
    Params p{};
    for (int i = 0; i < 31; ++i) p.in[i] = (const float*)d_in[i];
    p.out = (float*)d_out; p.ws = (unsigned char*)d_ws;
    (void)hipMemsetAsync((char*)d_ws + WS_CTL, 0, 1 * MiB, stream);
#if ONE_LAUNCH
    static int grid = 0;
    if (!grid) {
        int dev = 0, cus = 0, per_cu = 0;
        (void)hipGetDevice(&dev); (void)hipDeviceGetAttribute(&cus, hipDeviceAttributeMultiprocessorCount, dev);
        (void)hipFuncSetAttribute((const void*)k_mega, hipFuncAttributeMaxDynamicSharedMemorySize, LDS_BYTES);
        if (hipOccupancyMaxActiveBlocksPerMultiprocessor(&per_cu, (const void*)k_mega, NTHREADS, LDS_BYTES) != hipSuccess || per_cu < 1) { fprintf(stderr, "kernel_launch: occupancy query says %d blocks per CU\n", per_cu); (void)hipGetLastError(); }
        grid = cus > 0 ? cus : 256;
    }
    hipLaunchKernelGGL(k_mega, dim3(grid), dim3(NTHREADS), LDS_BYTES, stream, p);
    return;
#endif
    const int G = 256;
    for (int l = 0; l < 2; ++l) {
        launch_stage<ST_CONV>(p, l, G, stream);
        launch_stage<ST_PREP>(p, l, G, stream);
        if (FAST(ST_INPROJ)) launch_stage<ST_INPROJ>(p, l, G, stream); else tw::inproj<<<dim3(INC / 256, T), 256, 0, stream>>>(p, l);
        launch_stage<ST_POOL>(p, l, G, stream);
        if (FAST(ST_SGU)) launch_stage<ST_SGU>(p, l, G, stream); else { tw::sgu_stats<<<T, 256, 0, stream>>>(p); tw::sgu_mix<<<T * 512 / 256, 256, 0, stream>>>(p, l); }
        if (FAST(ST_SSMOUT)) { launch_stage<ST_SST>(p, l, G, stream); launch_stage<ST_SCAN>(p, l, G, stream); launch_stage<ST_SSMOUT>(p, l, G, stream); }
        else tw::ssm<<<128, 64, 0, stream>>>(p, l);
        if (FAST(ST_GLU)) launch_stage<ST_GLU>(p, l, G, stream); else tw::glu<<<dim3(2, T), 256, 0, stream>>>(p, l);
        if (FAST(ST_BRANCH)) launch_stage<ST_BRANCH>(p, l, G, stream); else tw::branch<<<dim3(4, T), 256, 0, stream>>>(p);
        if (FAST(ST_WOUT)) launch_stage<ST_WOUT>(p, l, G, stream); else tw::wout<<<dim3(4, T), 256, 0, stream>>>(p);
        launch_stage<ST_ROUTE>(p, l, G, stream);
        if (FAST(ST_MOE1)) { launch_stage<ST_MOE1>(p, l, G, stream); launch_stage<ST_MOE2>(p, l, G, stream); }
        else tw::moe<<<dim3(8192, 32), 256, 0, stream>>>(p, l);
    }
    launch_stage<ST_FINAL>(p, 0, G, stream);
}
```

```cpp
#include <hip/hip_runtime.h>
#include <math.h>
#include <stdio.h>

#ifndef FAST_MASK
#define FAST_MASK 0x45E4u
#endif
#ifndef DBL_MASK
#define DBL_MASK 0x0u
#endif
#ifndef ONE_LAUNCH
#define ONE_LAUNCH 1
#endif

#define LAS __attribute__((address_space(3)))
typedef unsigned short bf16_t;
typedef short bf16x8 __attribute__((ext_vector_type(8)));
typedef float f32x4 __attribute__((ext_vector_type(4)));
typedef float f32x2 __attribute__((ext_vector_type(2)));
typedef unsigned u32x4 __attribute__((ext_vector_type(4)));
typedef unsigned u32x2 __attribute__((ext_vector_type(2)));

constexpr int T = 16384, D = 1024, SEQ = 4096, INC = 5120, NE = 32, DE = 512;
constexpr int QC = 32;
constexpr int NCH = T / QC;
constexpr int UGLD = 640;
constexpr float EPS = 1e-6f;
constexpr int CAP = 32768;
constexpr int NTHREADS = 512;
constexpr int LDS_BYTES = 155648;

constexpr size_t MiB = 1u << 20;
constexpr size_t WS_CTL = 0;
constexpr size_t WS_WIN = 1 * MiB;
constexpr size_t WS_WB = WS_WIN + 10 * MiB;
constexpr size_t WS_WOUT = WS_WB + 3 * MiB;
constexpr size_t WS_GLU = WS_WOUT + 2 * MiB;
constexpr size_t WS_SGW = WS_GLU + MiB / 2;
constexpr size_t WS_ET = WS_SGW + MiB / 2;
constexpr size_t WS_TZF = WS_ET + 8 * MiB;
constexpr size_t WS_WGU = WS_TZF + 20 * MiB;
constexpr size_t WS_WD = WS_WGU + 64 * MiB;
constexpr size_t WS_HB = WS_WD + 32 * MiB;
constexpr size_t WS_PA = WS_HB + 32 * MiB;
constexpr size_t WS_UV = WS_PA + 16 * MiB;
constexpr size_t WS_UG = WS_UV + 32 * MiB;
constexpr size_t WS_YG = WS_UG + 20 * MiB;
constexpr size_t WS_SST = WS_YG + 16 * MiB;
constexpr size_t WS_MERGED = WS_SST + 8 * MiB;
constexpr size_t WS_GATES = WS_MERGED + 32 * MiB;
constexpr size_t WS_YS = WS_GATES + 96 * MiB;
constexpr size_t WS_END = WS_YS + 48 * MiB;
constexpr size_t WS_LIST = WS_GATES;
constexpr size_t WS_LW = WS_LIST + 4 * MiB;
constexpr size_t WS_ACT = WS_LW + 4 * MiB;
constexpr size_t WS_YB = WS_ACT + 40 * MiB;
static_assert(WS_YB + 64 * MiB <= WS_END, "moe overlay");
constexpr int CW_BAR = 0;
constexpr int CW_TQ = 4096;
constexpr int CW_CNT = 8192, CNT_STRIDE = 64;

struct Params {
    const float* in[31];
    float* out;
    unsigned char* ws;
};

__device__ __forceinline__ unsigned cvt_pk_bf16(float lo, float hi) { unsigned r; asm volatile("v_cvt_pk_bf16_f32 %0, %1, %2" : "=v"(r) : "v"(lo), "v"(hi)); return r; }
__device__ __forceinline__ bf16_t f2bf(float f) { return (bf16_t)(cvt_pk_bf16(f, 0.f) & 0xffffu); }
__device__ __forceinline__ float bf2f(bf16_t b) { return __uint_as_float(((unsigned)b) << 16); }
__device__ __forceinline__ float bflo(unsigned w) { return __uint_as_float(w << 16); }
__device__ __forceinline__ float bfhi(unsigned w) { return __uint_as_float(w & 0xffff0000u); }
__device__ __forceinline__ float fast_sigmoid(float x) { return __builtin_amdgcn_rcpf(1.0f + __builtin_amdgcn_exp2f(-1.4426950408889634f * x)); }
__device__ __forceinline__ float gelu_tanh_fast(float x) { const float z = 1.5957691216057308f * (x + 0.044715f * x * x * x); return x * fast_sigmoid(z); }
__device__ __forceinline__ float gelu_tanh_ref(float x) { return 0.5f * x * (1.0f + tanhf(0.7978845608028654f * (x + 0.044715f * x * x * x))); }
__device__ __forceinline__ float wave_sum(float v) {
    v += __int_as_float(__builtin_amdgcn_update_dpp(0, __float_as_int(v), 0xB1, 0xF, 0xF, false));
    v += __int_as_float(__builtin_amdgcn_update_dpp(0, __float_as_int(v), 0x4E, 0xF, 0xF, false));
    v += __int_as_float(__builtin_amdgcn_update_dpp(0, __float_as_int(v), 0x141, 0xF, 0xF, false));
    v += __int_as_float(__builtin_amdgcn_update_dpp(0, __float_as_int(v), 0x140, 0xF, 0xF, false));
    const int iv = __float_as_int(v);
    return (__int_as_float(__builtin_amdgcn_readlane(iv, 0)) + __int_as_float(__builtin_amdgcn_readlane(iv, 16))) + (__int_as_float(__builtin_amdgcn_readlane(iv, 32)) + __int_as_float(__builtin_amdgcn_readlane(iv, 48)));
}
__device__ __forceinline__ int opaque_tid(int wv) { unsigned m = ~0u; asm volatile("" : "+s"(m)); int t = wv * 64 + (int)__builtin_amdgcn_mbcnt_hi(m, __builtin_amdgcn_mbcnt_lo(m, 0u)); asm volatile("" : "+v"(t)); return t; }
__device__ __forceinline__ unsigned ld_agent(const unsigned* p) { return __hip_atomic_load(p, __ATOMIC_RELAXED, __HIP_MEMORY_SCOPE_AGENT); }

struct LayerPtrs {
    const float *norm_mix_g, *w_in, *b_gate, *pool_w, *pool_scale, *ln_g, *ln_b, *sgu_w, *sgu_b, *a_re, *a_im, *log_dt, *b_re, *b_im, *c_re, *c_im, *ssm_d, *glu_w, *glu_b,
        *w_branch, *w_out, *norm_ffn_g, *rgw, *rgb, *rew, *reb, *wg, *wu, *wd;
};
__device__ __host__ __forceinline__ LayerPtrs layer_ptrs(const Params& p, int l) {
    LayerPtrs q;
    q.norm_mix_g = p.in[1] + l * D; q.w_in = p.in[2] + (size_t)l * D * INC; q.b_gate = p.in[3] + l * 3 * D;
    q.pool_w = p.in[4] + (size_t)l * 4 * 128 * 128; q.pool_scale = p.in[5] + l * 512;
    q.ln_g = p.in[6] + l * 512; q.ln_b = p.in[7] + l * 512; q.sgu_w = p.in[8] + (size_t)l * 4 * 128 * 128; q.sgu_b = p.in[9] + l * 512;
    q.a_re = p.in[10] + l * 2048; q.a_im = p.in[11] + l * 2048; q.log_dt = p.in[12] + l * 32;
    q.b_re = p.in[13] + l * 32768; q.b_im = p.in[14] + l * 32768; q.c_re = p.in[15] + l * 32768; q.c_im = p.in[16] + l * 32768;
    q.ssm_d = p.in[17] + l * 512; q.glu_w = p.in[18] + (size_t)l * 512 * 512; q.glu_b = p.in[19] + l * 512;
    q.w_branch = p.in[20] + (size_t)l * 3 * 512 * 1024; q.w_out = p.in[21] + (size_t)l * D * D; q.norm_ffn_g = p.in[22] + l * D;
    q.rgw = p.in[23] + l * D * 4; q.rgb = p.in[24] + l * 4; q.rew = p.in[25] + l * D * 32; q.reb = p.in[26] + l * 32;
    q.wg = p.in[27] + (size_t)l * NE * D * DE; q.wu = p.in[28] + (size_t)l * NE * D * DE; q.wd = p.in[29] + (size_t)l * NE * DE * D;
    return q;
}
#define WSP(type, off) ((type*)(p.ws + (off)))

#define XB_TMO      128
#define XB_XCNT(j)  (256  + 64 * (j))
#define XB_XSUB(j)  (1280 + 64 * (j))
#define XB_XGEN(j)  (2304 + 64 * (j))
#define XB_TOP      3328
#define XB_TOPGEN   3392
#define XCD_BAR_WORDS 3456
#define XB_SPIN_CAP (1u << 18)

__device__ __forceinline__ unsigned xb_ld(unsigned* p)              { return __hip_atomic_load(p, __ATOMIC_RELAXED, __HIP_MEMORY_SCOPE_AGENT); }
__device__ __forceinline__ unsigned xb_add(unsigned* p, unsigned v) { return __hip_atomic_fetch_add(p, v, __ATOMIC_RELAXED, __HIP_MEMORY_SCOPE_AGENT); }
__device__ __forceinline__ unsigned xb_xcc_id() { return (unsigned)__builtin_amdgcn_s_getreg((3 << 11) | 20) & 0xFu; }
#define XB_SPIN(cond, bar) do { unsigned _sp = 0; while (cond) { __builtin_amdgcn_s_sleep(1); \
    if ((++_sp & 255u) == 0u) { if (xb_ld(&(bar)[XB_TMO])) break; if (_sp > XB_SPIN_CAP) { atomicAdd(&(bar)[XB_TMO], 1u); break; } } } } while (0)

struct XcdBarrier {
    unsigned* bar; unsigned x;
    volatile LAS unsigned* st;
    int wv;
};

__device__ __forceinline__ bool xb_thread0(int wv) { unsigned m = ~0u; asm volatile("" : "+s"(m)); return wv == 0 && __builtin_amdgcn_mbcnt_hi(m, __builtin_amdgcn_mbcnt_lo(m, 0u)) == 0u; }
__device__ __forceinline__ XcdBarrier xcd_barrier_post(unsigned* bar, volatile LAS unsigned* st, int wv) {
    XcdBarrier b; b.bar = bar; b.x = xb_xcc_id(); b.st = st; b.wv = wv;
    if (xb_thread0(wv)) (void)xb_add(&bar[XB_XCNT(b.x)], 1u);
    return b;
}
__device__ __forceinline__ void xcd_barrier_complete(unsigned* bar, unsigned x, unsigned& nloc, unsigned& nx) {
    const unsigned G = gridDim.x * gridDim.y * gridDim.z;
    unsigned sum, cnt, mine, sp = 0u;
    for (;;) {
        sum = 0u; cnt = 0u; mine = 0u;
#pragma unroll
        for (unsigned j = 0; j < 16; ++j) { const unsigned c = xb_ld(&bar[XB_XCNT(j)]); sum += c; cnt += (c > 0u) ? 1u : 0u; mine = (j == x) ? c : mine; }
        if (sum == G) break;
        __builtin_amdgcn_s_sleep(1);
        if ((++sp & 255u) == 0u) { if (xb_ld(&bar[XB_TMO])) break; if (sp > XB_SPIN_CAP) { atomicAdd(&bar[XB_TMO], 1u); break; } }
    }
    nloc = mine > 0u ? mine : 1u; nx = cnt > 0u ? cnt : 1u;
}

__device__ __forceinline__ void xcd_barrier(const XcdBarrier& b) {
    asm volatile("s_waitcnt vmcnt(0)" ::: "memory");
    __syncthreads();
    if (xb_thread0(b.wv)) {
        unsigned* bar = b.bar;
        __builtin_amdgcn_s_waitcnt(0);
        unsigned nloc = b.st[0], nx = b.st[1];
        if (nloc == 0u) { xcd_barrier_complete(bar, b.x, nloc, nx); b.st[0] = nloc; b.st[1] = nx; }
        const unsigned old = xb_add(&bar[XB_XSUB(b.x)], 1u);
        const unsigned gen = old / nloc;
        if (old + 1u == (gen + 1u) * nloc) {
            __builtin_amdgcn_fence(__ATOMIC_RELEASE, "agent");
            asm volatile("s_waitcnt vmcnt(0)" ::: "memory");
            const unsigned og = xb_add(&bar[XB_TOP], 1u);
            const unsigned tg = og / nx;
            if (og + 1u == (tg + 1u) * nx) xb_add(&bar[XB_TOPGEN], 1u);
            else XB_SPIN(xb_ld(&bar[XB_TOPGEN]) == tg, bar);
            __builtin_amdgcn_fence(__ATOMIC_ACQUIRE, "agent");
            xb_add(&bar[XB_XGEN(b.x)], 1u);
            asm volatile("s_waitcnt vmcnt(0)" ::: "memory");
        } else {
            XB_SPIN(xb_ld(&bar[XB_XGEN(b.x)]) == gen, bar);
            __builtin_amdgcn_fence(__ATOMIC_ACQUIRE, "agent");
            asm volatile("s_waitcnt vmcnt(0)" ::: "memory");
        }
    }
    __syncthreads();
}


namespace pg8 {
constexpr int BM = 256, BK = 64, HALF = 128, HTB = HALF * BK * 2, STAGE_BYTES = 8 * HTB;
__host__ __device__ __forceinline__ int lds_byte(int r, int c) { const int st = (r >> 4) * 2 + (c >> 5), rr = r & 15, cc = c & 31, ob = rr * 64 + cc * 2; return st * 1024 + (ob ^ (((ob >> 9) & 1) << 5)); }
__host__ __device__ __forceinline__ void stage_rc(int b, int& R, int& C) { const int st = b / 1024, sb = b % 1024, swz = sb ^ (((sb >> 9) & 1) << 5); R = (st >> 1) * 16 + swz / 64; C = (st & 1) * 32 + (swz % 64) / 2; }
__host__ __device__ __forceinline__ int perm32(int rho) { const int n = rho >> 4, i = rho & 15; return 8 * (i >> 2) + 4 * n + (i & 3); }
struct Unit { int pm, pn, e, p0, nvalid, prow, sub; };
template <class Epi, class Sched, bool ALIGN_EPI = true>
__device__ __forceinline__ void gemm_phase(LAS unsigned char* lds, const Sched& S, const Epi& E, int wv) {
    const int tid = opaque_tid(wv), wid = __builtin_amdgcn_readfirstlane(tid >> 6), lane = tid & 63, wr = wid >> 2, wc = wid & 3, fr = lane & 15, fq = lane >> 4;
    const int nt = S.K / BK;
    int R0, C0, R1, C1; stage_rc(tid * 16, R0, C0); stage_rc(tid * 16 + 8192, R1, C1);
    const int Rb0 = Epi::PERM ? ((R0 & ~31) + perm32(R0 & 31)) : R0, Rb1 = Epi::PERM ? ((R1 & ~31) + perm32(R1 & 31)) : R1;
    const unsigned vB0 = (unsigned)(Rb0 * S.ldb + C0) * 2u, vB1 = (unsigned)(Rb1 * S.ldb + C1) * 2u;
    const size_t kstep = (size_t)(BK * 2);
    const size_t hstepB = (size_t)HALF * S.ldb * 2;
    const unsigned ldsw = (unsigned)wid * 1024u;
    const int aoff = lds_byte(wr * 64 + fr, fq * 8), boff = lds_byte(wc * 32 + fr, fq * 8);
#define PG8_SA(b, h) (((b) * 2 + (h)) * HTB)
#define PG8_SB(b, h) ((4 + (b) * 2 + (h)) * HTB)
#define PG8_STAGE2(bufoff, gbase, o0, o1) do { \
        __builtin_amdgcn_global_load_lds((const unsigned*)((const char*)(gbase) + (o0)), (LAS unsigned*)(lds + (bufoff) + ldsw), 16, 0, 0); \
        __builtin_amdgcn_global_load_lds((const unsigned*)((const char*)(gbase) + (o1)), (LAS unsigned*)(lds + (bufoff) + ldsw + 8192), 16, 0, 0); } while (0)
#define PG8_LDA(dst, b, h) do { _Pragma("unroll") for (int m = 0; m < 4; ++m) _Pragma("unroll") for (int k = 0; k < 2; ++k) dst[m][k] = *(const LAS bf16x8*)(lds + PG8_SA(b, h) + aoff + m * 2048 + k * 1024); } while (0)
#define PG8_LDB(dst, b, h) do { _Pragma("unroll") for (int n = 0; n < 2; ++n) _Pragma("unroll") for (int k = 0; k < 2; ++k) dst[n][k] = *(const LAS bf16x8*)(lds + PG8_SB(b, h) + boff + n * 2048 + k * 1024); } while (0)
#define PG8_MMA(ai, bj, At, Bt) do { __builtin_amdgcn_s_setprio(1); _Pragma("unroll") for (int m = 0; m < 4; ++m) _Pragma("unroll") for (int n = 0; n < 2; ++n) _Pragma("unroll") for (int k = 0; k < 2; ++k) \
        acc[ai][bj][m][n] = __builtin_amdgcn_mfma_f32_16x16x32_bf16(Bt[n][k], At[m][k], acc[ai][bj][m][n], 0, 0, 0); __builtin_amdgcn_s_setprio(0); } while (0)
#define PG8_WAIT_V(n) asm volatile("s_waitcnt vmcnt(" #n ")" ::: "memory")
#define PG8_WAIT_L(n) asm volatile("s_waitcnt lgkmcnt(" #n ")" ::: "memory")
#define PG8_BAR __builtin_amdgcn_s_barrier()
#define PG8_SCHED __builtin_amdgcn_sched_barrier(0)
    Unit cur, nxt; int ui = 0;
    if (!S.next(0, cur)) return;
    f32x4 acc[2][2][4][2];
#pragma unroll
    for (int a = 0; a < 2; ++a)
#pragma unroll
        for (int b = 0; b < 2; ++b)
#pragma unroll
            for (int m = 0; m < 4; ++m)
#pragma unroll
                for (int n = 0; n < 2; ++n) acc[a][b][m][n] = (f32x4){0.f, 0.f, 0.f, 0.f};
    bf16x8 At[4][2], B0[2][2], B1[2][2];
    const char* cA = S.a_base(cur); const char* cB = S.b_base(cur);
    unsigned c00 = S.a_off(cur, R0, C0), c01 = S.a_off(cur, R1, C1), c10 = S.a_off(cur, HALF + R0, C0), c11 = S.a_off(cur, HALF + R1, C1);
    PG8_STAGE2(PG8_SB(0, 0), cB, vB0, vB1); PG8_STAGE2(PG8_SB(0, 1), cB + hstepB, vB0, vB1); PG8_STAGE2(PG8_SA(0, 0), cA, c00, c01); PG8_STAGE2(PG8_SA(0, 1), cA, c10, c11);
    if (wr == 1) PG8_BAR;
    PG8_WAIT_V(2); PG8_BAR;
    PG8_STAGE2(PG8_SB(1, 0), cB + kstep, vB0, vB1); PG8_STAGE2(PG8_SA(1, 0), cA + kstep, c00, c01); PG8_STAGE2(PG8_SB(1, 1), cB + hstepB + kstep, vB0, vB1);
    PG8_WAIT_V(6); PG8_BAR;
    for (;;) {
        const bool has_next = S.next(ui + 1, nxt);
        const char* nA = has_next ? S.a_base(nxt) : cA; const char* nB = has_next ? S.b_base(nxt) : cB;
        unsigned n00 = c00, n01 = c01, n10 = c10, n11 = c11;
        if (has_next) { n00 = S.a_off(nxt, R0, C0); n01 = S.a_off(nxt, R1, C1); n10 = S.a_off(nxt, HALF + R0, C0); n11 = S.a_off(nxt, HALF + R1, C1); }
        for (int t = 0; t < nt; t += 2) {
            const bool last = (t == nt - 2);
            const char* a1 = cA + (size_t)(t + 1) * kstep;
            const char* a2 = last ? nA : cA + (size_t)(t + 2) * kstep; const char* b2 = last ? nB : cB + (size_t)(t + 2) * kstep;
            const char* a3 = a2 + kstep; const char* b3 = b2 + kstep;
            const unsigned s00 = last ? n00 : c00, s01 = last ? n01 : c01, s10 = last ? n10 : c10, s11 = last ? n11 : c11;
            PG8_LDB(B0, 0, 0); PG8_LDB(B1, 0, 1); PG8_SCHED; PG8_LDA(At, 0, 0); PG8_STAGE2(PG8_SA(1, 1), a1, c10, c11);
            PG8_WAIT_V(8); PG8_WAIT_L(0); PG8_BAR; PG8_MMA(0, 0, At, B0); PG8_MMA(0, 1, At, B1); PG8_BAR; PG8_SCHED;
            PG8_LDA(At, 0, 1); PG8_STAGE2(PG8_SB(0, 0), b2, vB0, vB1); PG8_STAGE2(PG8_SB(0, 1), b2 + hstepB, vB0, vB1); PG8_STAGE2(PG8_SA(0, 0), a2, s00, s01);
            PG8_WAIT_V(8); PG8_WAIT_L(0); PG8_BAR; PG8_MMA(1, 0, At, B0); PG8_MMA(1, 1, At, B1); PG8_BAR; PG8_SCHED;
            PG8_LDB(B0, 1, 0); PG8_LDB(B1, 1, 1); PG8_SCHED; PG8_LDA(At, 1, 0); PG8_STAGE2(PG8_SA(0, 1), a2, s10, s11);
            PG8_WAIT_V(8); PG8_WAIT_L(0); PG8_BAR; PG8_MMA(0, 0, At, B0); PG8_MMA(0, 1, At, B1); PG8_BAR; PG8_SCHED;
            PG8_LDA(At, 1, 1); PG8_STAGE2(PG8_SB(1, 0), b3, vB0, vB1); PG8_STAGE2(PG8_SB(1, 1), b3 + hstepB, vB0, vB1); PG8_STAGE2(PG8_SA(1, 0), a3, s00, s01);
            PG8_WAIT_V(8); PG8_WAIT_L(0); PG8_BAR; PG8_MMA(1, 0, At, B0); PG8_MMA(1, 1, At, B1); PG8_BAR; PG8_SCHED;
        }
        if constexpr (ALIGN_EPI) { if (wr == 0) PG8_BAR; }
        E(acc, cur, wr, wc, fr, fq);
        if (!has_next) break;
        if (!(Epi::ACCUM && cur.sub + 1 < S.nsub)) {
#pragma unroll
        for (int a = 0; a < 2; ++a)
#pragma unroll
            for (int b = 0; b < 2; ++b)
#pragma unroll
                for (int m = 0; m < 4; ++m)
#pragma unroll
                    for (int n = 0; n < 2; ++n) acc[a][b][m][n] = (f32x4){0.f, 0.f, 0.f, 0.f};
        }
        cur = nxt; cA = nA; cB = nB; c00 = n00; c01 = n01; c10 = n10; c11 = n11; ++ui;
        if constexpr (ALIGN_EPI) { if (wr == 1) PG8_BAR; }
    }
    PG8_WAIT_V(0);
    if constexpr (!ALIGN_EPI) { if (wr == 0) PG8_BAR; }
    PG8_BAR;
#undef PG8_SA
#undef PG8_SB
#undef PG8_STAGE2
#undef PG8_LDA
#undef PG8_LDB
#undef PG8_MMA
#undef PG8_WAIT_V
#undef PG8_WAIT_L
#undef PG8_BAR
#undef PG8_SCHED
}

struct DenseOrder {
    const char* A; const char* Bt; int lda, ldb, K; int nM, nN, nwg, G, c, nsub;
    __device__ void init(const void* A_, int lda_, const void* Bt_, int ldb_, int M, int N, int K_, int G_, int c_, int nsub_ = 1) { A = (const char*)A_; Bt = (const char*)Bt_; lda = lda_; ldb = ldb_; K = K_; nM = M / BM; nN = N / BM; nwg = nM * nN; G = G_; c = c_; nsub = nsub_; }
    __device__ bool next(int i, Unit& u) const {
        u.sub = i % nsub; i /= nsub;
        const long L = (long)i * G + c; if (L >= nwg) return false;
        int wgid = (int)L; { const int q = nwg / 8, r = nwg % 8, xcd = wgid % 8, off = wgid / 8; wgid = (xcd < r ? xcd * (q + 1) : r * (q + 1) + (xcd - r) * q) + off; }
        const int nig = 8 * nN, gid = wgid / nig, fm = gid * 8, gsz = (nM - fm) < 8 ? (nM - fm) : 8;
        u.pm = fm + ((wgid % nig) % gsz); u.pn = (wgid % nig) / gsz; u.e = 0; u.p0 = 0; u.nvalid = 256; u.prow = 0; return true;
    }
    __device__ __forceinline__ const char* a_base(const Unit& u) const { return A + (size_t)u.pm * BM * lda * 2 + (size_t)u.sub * K * 2; }
    __device__ __forceinline__ const char* b_base(const Unit& u) const { return Bt + (size_t)u.pn * BM * ldb * 2 + (size_t)u.sub * K * 2; }
    __device__ __forceinline__ unsigned a_off(const Unit&, int row, int col) const { return (unsigned)(row * lda + col) * 2u; }
};
struct GroupOrder {
    static constexpr int nsub = 1;
    const char* A; const char* Bt; size_t strideA, strideB; int lda, ldb, K; int nM, nN, nwg, G, c;
    __device__ void init(const void* A_, size_t sA, int lda_, const void* Bt_, size_t sB, int ldb_, int ngroups, int M, int N, int K_, int G_, int c_) {
        A = (const char*)A_; Bt = (const char*)Bt_; strideA = sA; strideB = sB; lda = lda_; ldb = ldb_; K = K_; nM = M / BM; nN = N / BM; nwg = ngroups * nM * nN; G = G_; c = c_; }
    __device__ bool next(int i, Unit& u) const {
        const long L = (long)i * G + c; if (L >= nwg) return false;
        const int per = nM * nN; u.e = (int)L / per; const int r = (int)L % per; u.pm = r / nN; u.pn = r % nN; u.p0 = 0; u.nvalid = 256; u.prow = 0; u.sub = 0; return true;
    }
    __device__ __forceinline__ const char* a_base(const Unit& u) const { return A + (size_t)u.e * strideA + (size_t)u.pm * BM * lda * 2; }
    __device__ __forceinline__ const char* b_base(const Unit& u) const { return Bt + (size_t)u.e * strideB + (size_t)u.pn * BM * ldb * 2; }
    __device__ __forceinline__ unsigned a_off(const Unit&, int row, int col) const { return (unsigned)(row * lda + col) * 2u; }
};
__device__ __forceinline__ void moe_table(LAS unsigned* tab, const unsigned* cnt, int tid) {
    if (tid < NE) tab[32 + tid] = ld_agent(cnt + tid * CNT_STRIDE);
    __syncthreads();
    if (tid < NE) { unsigned acc = 0; for (int e = 0; e < tid; ++e) acc += (tab[32 + e] + 255u) >> 8; tab[tid] = acc; }
    __syncthreads();
}
template <bool GATHER>
struct MoeOrder {
    static constexpr int nsub = 1;
    const char* A; const char* Bt; size_t strideB; int lda, ldb, K; int nN, G, c; const LAS unsigned* tab; const int* list; int lane;
    __device__ __forceinline__ bool next(int i, Unit& u) const {
        const int uu = i * G + c; const int q = uu / nN; u.pn = uu % nN;
        const int p = (int)tab[lane & 31], n = (int)tab[32 + (lane & 31)], np = (n + 255) >> 8;
        const unsigned long long hit = __builtin_amdgcn_ballot_w64(lane < 32 && q >= p && q < p + np);
        if (hit == 0ull) return false;
        const int e = (int)__builtin_ctzll(hit); const int pe = __builtin_amdgcn_readlane(p, e), ne = __builtin_amdgcn_readlane(n, e);
        u.e = e; u.p0 = (q - pe) * 256; u.nvalid = (ne - u.p0) < 256 ? (ne - u.p0) : 256; u.pm = q; u.prow = q * 256; u.sub = 0; return true;
    }
    __device__ __forceinline__ const char* a_base(const Unit& u) const { return GATHER ? A : A + (size_t)u.prow * lda * 2; }
    __device__ __forceinline__ const char* b_base(const Unit& u) const { return Bt + (size_t)u.e * strideB + (size_t)u.pn * BM * ldb * 2; }
    __device__ __forceinline__ unsigned a_off(const Unit& u, int row, int col) const {
        if (GATHER) { int tok = 0; if (row < u.nvalid) tok = (int)ld_agent((const unsigned*)list + (size_t)u.e * CAP + u.p0 + row) >> 1; return (unsigned)(tok * lda + col) * 2u; }
        return (unsigned)(row * lda + col) * 2u;
    }
};
}

using pg8::Unit;
#define EPI_LOOP_AI_M _Pragma("unroll") for (int ai = 0; ai < 2; ++ai) _Pragma("unroll") for (int m = 0; m < 4; ++m)
__device__ __forceinline__ u32x4 pack8(const f32x4& a, const f32x4& b) { u32x4 w; w.x = cvt_pk_bf16(a[0], a[1]); w.y = cvt_pk_bf16(a[2], a[3]); w.z = cvt_pk_bf16(b[0], b[1]); w.w = cvt_pk_bf16(b[2], b[3]); return w; }
__device__ __forceinline__ void unpack8(const u32x4& w, f32x4& a, f32x4& b) { a = (f32x4){bflo(w.x), bfhi(w.x), bflo(w.y), bfhi(w.y)}; b = (f32x4){bflo(w.z), bfhi(w.z), bflo(w.w), bfhi(w.w)}; }

struct EpiInProj {
    static constexpr bool PERM = true, ACCUM = false;
    bf16_t* PA; bf16_t* UV; bf16_t* UG; bf16_t* GATES; const float* bgate;
    __device__ __forceinline__ void operator()(f32x4 (&acc)[2][2][4][2], const Unit& u, int wr, int wc, int fr, int fq) const {
        const int row0 = u.pm * 256 + wr * 64 + fr, colt = u.pn * 256 + wc * 32 + 8 * fq;
        EPI_LOOP_AI_M { const int r = row0 + ai * 128 + m * 16;
#pragma unroll
            for (int bj = 0; bj < 2; ++bj) { const int c = colt + bj * 128; f32x4 v0 = acc[ai][bj][m][0], v1 = acc[ai][bj][m][1]; bf16_t* dst;
                if (u.pn < 2) dst = PA + (size_t)r * 512 + c;
                else if (u.pn < 6) { dst = UV + (size_t)r * 1024 + (c - 512);
#pragma unroll
                    for (int j = 0; j < 4; ++j) { v0[j] = gelu_tanh_fast(v0[j]); v1[j] = gelu_tanh_fast(v1[j]); } }
                else if (u.pn < 8) { const int cs = c - 1536, g = cs >> 4, cc = cs & 15, n = r >> 5, s = r & 31; dst = UG + ((size_t)(g * NCH + n) * UGLD + s * 16 + cc); }
                else { const int cg = c - 2048; dst = GATES + (size_t)r * 3072 + cg; const f32x4 b0 = *(const f32x4*)(bgate + cg), b1 = *(const f32x4*)(bgate + cg + 4);
#pragma unroll
                    for (int j = 0; j < 4; ++j) { v0[j] = fast_sigmoid(v0[j] + b0[j]); v1[j] = fast_sigmoid(v1[j] + b1[j]); } }
                *(u32x4*)dst = pack8(v0, v1); } }
    }
};
struct EpiSst {
    static constexpr bool PERM = false, ACCUM = false;
    float* SST;
    __device__ __forceinline__ void operator()(f32x4 (&acc)[2][2][4][2], const Unit& u, int wr, int wc, int fr, int fq) const {
        const int row0 = u.pm * 256 + wr * 64 + fr, col0 = wc * 32 + 4 * fq;
        EPI_LOOP_AI_M { float* rowp = SST + ((size_t)u.e * NCH + row0 + ai * 128 + m * 16) * 128 + col0;
#pragma unroll
            for (int n = 0; n < 2; ++n) *(f32x4*)(rowp + n * 16) = acc[ai][0][m][n]; }
    }
};
struct EpiSsmOut {
    static constexpr bool PERM = true, ACCUM = false;
    bf16_t* YG;
    __device__ __forceinline__ void operator()(f32x4 (&acc)[2][2][4][2], const Unit& u, int wr, int wc, int fr, int fq) const {
        const int row0 = u.pm * 256 + wr * 64 + fr, colt = u.pn * 256 + wc * 32 + 8 * fq;
        EPI_LOOP_AI_M { const int n = row0 + ai * 128 + m * 16;
#pragma unroll
            for (int bj = 0; bj < 2; ++bj) { const int c = colt + bj * 128, t = c >> 4, cc = c & 15; f32x4 v0 = acc[ai][bj][m][0], v1 = acc[ai][bj][m][1];
#pragma unroll
                for (int j = 0; j < 4; ++j) { v0[j] = gelu_tanh_fast(v0[j]); v1[j] = gelu_tanh_fast(v1[j]); }
                *(u32x4*)(YG + (size_t)(n * QC + t) * 512 + u.e * 16 + cc) = pack8(v0, v1); } }
    }
};
struct EpiGlu {
    static constexpr bool PERM = true, ACCUM = false;
    const bf16_t* YG; bf16_t* YS; const float* gb;
    __device__ __forceinline__ void operator()(f32x4 (&acc)[2][2][4][2], const Unit& u, int wr, int wc, int fr, int fq) const {
        const int row0 = u.pm * 256 + wr * 64 + fr, colt = u.pn * 256 + wc * 32 + 8 * fq;
        EPI_LOOP_AI_M { const int r = row0 + ai * 128 + m * 16;
#pragma unroll
            for (int bj = 0; bj < 2; ++bj) { const int c = colt + bj * 128; f32x4 v0 = acc[ai][bj][m][0], v1 = acc[ai][bj][m][1], y0, y1;
                const f32x4 b0 = *(const f32x4*)(gb + c), b1 = *(const f32x4*)(gb + c + 4);
                unpack8(*(const u32x4*)(YG + (size_t)r * 512 + c), y0, y1);
#pragma unroll
                for (int j = 0; j < 4; ++j) { v0[j] = y0[j] * fast_sigmoid(v0[j] + b0[j]); v1[j] = y1[j] * fast_sigmoid(v1[j] + b1[j]); }
                *(u32x4*)(YS + (size_t)r * 1536 + 1024 + c) = pack8(v0, v1); }
            asm volatile("" ::: "memory"); }
    }
};
struct EpiBranch {
    static constexpr bool PERM = true, ACCUM = true;
    const bf16_t* GATES; bf16_t* MERGED;
    __device__ __forceinline__ void operator()(f32x4 (&acc)[2][2][4][2], const Unit& u, int wr, int wc, int fr, int fq) const {
        const int row0 = u.pm * 256 + wr * 64 + fr, colt = u.pn * 256 + wc * 32 + 8 * fq;
        if (u.sub < 2) {
            EPI_LOOP_AI_M { const int r = row0 + ai * 128 + m * 16;
#pragma unroll
                for (int bj = 0; bj < 2; ++bj) { const int c = colt + bj * 128; f32x4 a0, a1, b0, b1;
                    unpack8(*(const u32x4*)(GATES + (size_t)r * 3072 + u.sub * 1024 + c), a0, a1); unpack8(*(const u32x4*)(GATES + (size_t)r * 3072 + (u.sub + 1) * 1024 + c), b0, b1);
#pragma unroll
                    for (int j = 0; j < 4; ++j) { acc[ai][bj][m][0][j] *= a0[j] * __builtin_amdgcn_rcpf(b0[j]); acc[ai][bj][m][1][j] *= a1[j] * __builtin_amdgcn_rcpf(b1[j]); } }
                asm volatile("" ::: "memory"); }
        } else {
            EPI_LOOP_AI_M { const int r = row0 + ai * 128 + m * 16;
#pragma unroll
                for (int bj = 0; bj < 2; ++bj) { const int c = colt + bj * 128; f32x4 g0, g1;
                    unpack8(*(const u32x4*)(GATES + (size_t)r * 3072 + 2048 + c), g0, g1);
                    *(u32x4*)(MERGED + (size_t)r * 1024 + c) = pack8(acc[ai][bj][m][0] * g0, acc[ai][bj][m][1] * g1); }
                asm volatile("" ::: "memory"); }
        }
    }
};
struct EpiWout {
    static constexpr bool PERM = false, ACCUM = false;
    float* X;
    __device__ __forceinline__ void operator()(f32x4 (&acc)[2][2][4][2], const Unit& u, int wr, int wc, int fr, int fq) const {
        const int row0 = u.pm * 256 + wr * 64 + fr, col0 = u.pn * 256 + wc * 32 + 4 * fq;
        EPI_LOOP_AI_M { float* rowp = X + (size_t)(row0 + ai * 128 + m * 16) * 1024 + col0;
#pragma unroll
            for (int bj = 0; bj < 2; ++bj)
#pragma unroll
                for (int n = 0; n < 2; ++n) { f32x4* q = (f32x4*)(rowp + bj * 128 + n * 16); *q = *q + acc[ai][bj][m][n]; }
            asm volatile("" ::: "memory"); }
    }
};
struct EpiMoe1 {
    static constexpr bool PERM = true, ACCUM = false;
    bf16_t* ACT; const float* LW;
    __device__ __forceinline__ void operator()(f32x4 (&acc)[2][2][4][2], const Unit& u, int wr, int wc, int fr, int fq) const {
        const int rl0 = wr * 64 + fr, j0 = wc * 32 + 8 * fq;
        EPI_LOOP_AI_M { const int rl = rl0 + ai * 128 + m * 16; float w = 0.f;
            if (rl < u.nvalid) w = __uint_as_float(ld_agent((const unsigned*)LW + (size_t)u.e * CAP + u.p0 + rl));
            f32x4 g0 = acc[ai][0][m][0], g1 = acc[ai][0][m][1]; const f32x4 u0 = acc[ai][1][m][0], u1 = acc[ai][1][m][1];
#pragma unroll
            for (int j = 0; j < 4; ++j) { g0[j] = w * g0[j] * fast_sigmoid(g0[j]) * u0[j]; g1[j] = w * g1[j] * fast_sigmoid(g1[j]) * u1[j]; }
            *(u32x4*)(ACT + (size_t)(u.prow + rl) * 512 + u.pn * 128 + j0) = pack8(g0, g1); }
    }
};
struct EpiMoe2 {
    static constexpr bool PERM = true, ACCUM = false;
    bf16_t* YB; const int* LIST;
    __device__ __forceinline__ void operator()(f32x4 (&acc)[2][2][4][2], const Unit& u, int wr, int wc, int fr, int fq) const {
        const int rl0 = wr * 64 + fr, colt = u.pn * 256 + wc * 32 + 8 * fq;
        EPI_LOOP_AI_M { const int rl = rl0 + ai * 128 + m * 16;
            if (rl < u.nvalid) { const int idx = (int)ld_agent((const unsigned*)LIST + (size_t)u.e * CAP + u.p0 + rl); const int tok = idx >> 1, slot = idx & 1;
                bf16_t* rowp = YB + ((size_t)slot * T + tok) * 1024 + colt;
#pragma unroll
                for (int bj = 0; bj < 2; ++bj) *(u32x4*)(rowp + bj * 128) = pack8(acc[ai][bj][m][0], acc[ai][bj][m][1]); } }
    }
};

__device__ __forceinline__ void conv_tile_wave(const float* src, int ldsrc, bf16_t* dst, int ldd, LAS float* tile, int lane) {
    const int r = lane >> 4, c4 = (lane & 15) * 4;
    f32x4 v[16];
#pragma unroll
    for (int q = 0; q < 16; ++q) v[q] = __builtin_nontemporal_load((const f32x4*)(src + (size_t)(4 * q + r) * ldsrc + c4));
#pragma unroll
    for (int q = 0; q < 16; ++q) { LAS float* t = tile + (4 * q + r) * 65 + c4; t[0] = v[q][0]; t[1] = v[q][1]; t[2] = v[q][2]; t[3] = v[q][3]; }
    asm volatile("s_waitcnt lgkmcnt(0)" ::: "memory");
    const int jj = lane >> 3, kc = (lane & 7) * 8;
#pragma unroll
    for (int i2 = 0; i2 < 8; ++i2) { const int j = jj + 8 * i2; float x[8];
#pragma unroll
        for (int i = 0; i < 8; ++i) x[i] = tile[(kc + i) * 65 + j];
        u32x4 w; w.x = cvt_pk_bf16(x[0], x[1]); w.y = cvt_pk_bf16(x[2], x[3]); w.z = cvt_pk_bf16(x[4], x[5]); w.w = cvt_pk_bf16(x[6], x[7]);
        *(u32x4*)(dst + (size_t)j * ldd + kc) = w; }
    asm volatile("s_waitcnt lgkmcnt(0)" ::: "memory");
}
constexpr int CV_WIN = 1280, CV_WB = 256, CV_WOUT = 256, CV_GLU = 64, CV_GU = 8192, CV_DN = 4096;
constexpr int CV_TILES = CV_WIN + CV_WB + CV_WOUT + CV_GLU + CV_GU + CV_DN;
constexpr int CV_WEFF = 256;
constexpr int CV_SGW = 128;
constexpr int CV_SSM = 128;
constexpr int CV_BLK = CV_SSM + CV_WEFF + CV_SGW;

__device__ __forceinline__ void ssm_precompute(const Params& p, const LayerPtrs& L, int g, int q, LAS unsigned char* lds, int wv);

__device__ __forceinline__ void st_conv(const Params& p, int l, int bid, int nb, LAS unsigned char* lds, int wv) {
    const LayerPtrs L = layer_ptrs(p, l);
    bf16_t* WIN = WSP(bf16_t, WS_WIN); bf16_t* WB = WSP(bf16_t, WS_WB); bf16_t* WOUT = WSP(bf16_t, WS_WOUT); bf16_t* GLU = WSP(bf16_t, WS_GLU);
    bf16_t* WGU = WSP(bf16_t, WS_WGU); bf16_t* WD = WSP(bf16_t, WS_WD); bf16_t* SGW = WSP(bf16_t, WS_SGW);
    for (int u = bid; u < CV_BLK; u += nb) {
        int i = u;
        if (i < CV_SSM) { ssm_precompute(p, L, i >> 2, i & 3, lds, wv); continue; }
        i -= CV_SSM;
        if (i < CV_WEFF) {
            const int tid = opaque_tid(wv); const int kk = 2 * i + (tid >> 8), n4 = (tid & 255) * 4, g = kk >> 7, c = kk & 127; f32x4 acc = {0.f, 0.f, 0.f, 0.f};
            const float* pw = L.pool_w + ((size_t)g * 128 + c) * 128; const float* sc = L.pool_scale + g * 128; const float* wb = L.w_branch + (size_t)(g * 128) * 1024 + n4;
#pragma unroll 16
            for (int d = 0; d < 128; ++d) { const f32x4 w = *(const f32x4*)(wb + (size_t)d * 1024); acc = acc + w * (pw[d] * sc[d]); }
#pragma unroll
            for (int j = 0; j < 4; ++j) WB[(size_t)(n4 + j) * 1536 + kk] = f2bf(acc[j]);
            continue; }
        i -= CV_WEFF;
        { const int o = i * 512 + opaque_tid(wv); const int sidx = o & 127, t = (o >> 7) & 127; SGW[o] = (sidx <= t) ? f2bf(L.sgu_w[o]) : (bf16_t)0; }
    }
    __syncthreads();
    const int tid = opaque_tid(wv), lane = tid & 63; LAS float* tile = (LAS float*)lds + wv * (64 * 65);
    const bool skew = (nb == 256); const int hi = skew && bid >= 128; const int w0 = skew ? ((hi ? bid - 128 : bid) * 8 + wv) : bid * 8 + wv;
    const int ustart = skew ? (hi ? w0 : 8192 + w0) : w0, ustep = skew ? 1024 : nb * 8, uend = (skew && hi) ? 8192 : CV_TILES;
    for (int u = ustart; u < uend; u += ustep) {
        int i = u; const float* src; int ldsrc; bf16_t* dst; int ldd;
        if (i < CV_WIN) { const int k0 = (i & 15) * 64, n0 = (i >> 4) * 64; src = L.w_in + (size_t)k0 * INC + n0; ldsrc = INC; dst = WIN + (size_t)n0 * 1024 + k0; ldd = 1024; }
        else if ((i -= CV_WIN) < CV_WB) { const int k = 1 + (i >> 7), sx = i & 127, k0 = (sx & 7) * 64, n0 = (sx >> 3) * 64; src = L.w_branch + (size_t)k * 512 * 1024 + (size_t)k0 * 1024 + n0; ldsrc = 1024; dst = WB + (size_t)n0 * 1536 + k * 512 + k0; ldd = 1536; }
        else if ((i -= CV_WB) < CV_WOUT) { const int k0 = (i & 15) * 64, n0 = (i >> 4) * 64; src = L.w_out + (size_t)k0 * 1024 + n0; ldsrc = 1024; dst = WOUT + (size_t)n0 * 1024 + k0; ldd = 1024; }
        else if ((i -= CV_WOUT) < CV_GLU) { const int k0 = (i & 7) * 64, n0 = (i >> 3) * 64; src = L.glu_w + (size_t)k0 * 512 + n0; ldsrc = 512; dst = GLU + (size_t)n0 * 512 + k0; ldd = 512; }
        else if ((i -= CV_GLU) < CV_GU) { const int e = i >> 8, sx = i & 255, isup = sx >> 7, ss = sx & 127, k0 = (ss & 15) * 64, n0 = (ss >> 4) * 64;
            src = (isup ? L.wu : L.wg) + (size_t)e * 1024 * 512 + (size_t)k0 * 512 + n0; ldsrc = 512;
            dst = WGU + (size_t)e * 1024 * 1024 + (size_t)(256 * (n0 >> 7) + (n0 & 127) + (isup ? 128 : 0)) * 1024 + k0; ldd = 1024; }
        else { i -= CV_GU; const int e = i >> 7, sx = i & 127, k0 = (sx & 7) * 64, n0 = (sx >> 3) * 64; src = L.wd + (size_t)e * 512 * 1024 + (size_t)k0 * 1024 + n0; ldsrc = 1024; dst = WD + (size_t)e * 1024 * 512 + (size_t)n0 * 512 + k0; ldd = 512; }
        conv_tile_wave(src, ldsrc, dst, ldd, tile, lane);
    }
    __syncthreads();
}

__device__ __forceinline__ void ssm_precompute(const Params& p, const LayerPtrs& L, int g, int q, LAS unsigned char* lds, int wv) {
    LAS f32x2* LP = (LAS f32x2*)lds; LAS f32x2* BB = (LAS f32x2*)(lds + 16896); LAS f32x2* CC = (LAS f32x2*)(lds + 16896 + 8192); LAS float* KM = (LAS float*)(lds + 16896 + 16384);
    bf16_t* ET = WSP(bf16_t, WS_ET) + (size_t)g * 256 * 512; bf16_t* TZF = WSP(bf16_t, WS_TZF) + (size_t)g * 512 * UGLD;
    const int tid = opaque_tid(wv); const float dt = expf(L.log_dt[g]);
    for (int o = tid; o < 33 * 64; o += NTHREADS) { const int j = o >> 6, pp = o & 63; const float lre = L.a_re[g * 64 + pp], lim = L.a_im[g * 64 + pp];
        const float er = expf((float)j * lre * dt); LP[o] = (f32x2){er * cosf((float)j * lim * dt), er * sinf((float)j * lim * dt)}; }
    for (int o = tid; o < 64 * 16; o += NTHREADS) { const int pp = o >> 4; const float lre = L.a_re[g * 64 + pp], lim = L.a_im[g * 64 + pp];
        const float er = expf(lre * dt), lbr = er * cosf(lim * dt), lbi = er * sinf(lim * dt); const float nr = lbr - 1.f, ni = lbi, den = lre * lre + lim * lim;
        const float cr = (nr * lre + ni * lim) / den, ci = (ni * lre - nr * lim) / den; const float br = L.b_re[(size_t)g * 1024 + o], bi = L.b_im[(size_t)g * 1024 + o];
        BB[o] = (f32x2){cr * br - ci * bi, cr * bi + ci * br}; }
    for (int o = tid; o < 16 * 64; o += NTHREADS) CC[o] = (f32x2){L.c_re[(size_t)g * 1024 + o], L.c_im[(size_t)g * 1024 + o]};
    __syncthreads();
    const int nj = 8 * q + 8;
    for (int o = tid; o < nj * 256; o += NTHREADS) { const int j = o >> 8, c = (o >> 4) & 15, c2 = o & 15; float s = 0.f;
        for (int pp = 0; pp < 64; ++pp) { const f32x2 cv = CC[c * 64 + pp], lp = LP[j * 64 + pp], bb = BB[pp * 16 + c2];
            const float mr = cv.x * lp.x - cv.y * lp.y, mi = cv.x * lp.y + cv.y * lp.x; s += mr * bb.x - mi * bb.y; }
        if (j == 0 && c == c2) s += L.ssm_d[g * 16 + c];
        KM[o] = s; }
    __syncthreads();
    for (int o = tid; o < 64 * 64; o += NTHREADS) { const int rr = 64 * q + (o >> 6), k8 = (o & 63) * 8; float v[8];
#pragma unroll
        for (int i = 0; i < 8; ++i) { float x = 0.f; if (rr < 128) { const int pp = rr >> 1, ri = rr & 1, k = k8 + i, s = k >> 4, c2 = k & 15; const f32x2 lp = LP[(31 - s) * 64 + pp], bb = BB[pp * 16 + c2];
                x = ri ? (lp.x * bb.y + lp.y * bb.x) : (lp.x * bb.x - lp.y * bb.y); } v[i] = x; }
        u32x4 w; w.x = cvt_pk_bf16(v[0], v[1]); w.y = cvt_pk_bf16(v[2], v[3]); w.z = cvt_pk_bf16(v[4], v[5]); w.w = cvt_pk_bf16(v[6], v[7]);
        *(u32x4*)(ET + (size_t)rr * 512 + k8) = w; }
    for (int o = tid; o < 128 * 80; o += NTHREADS) { const int row = 128 * q + o / 80, k8 = (o % 80) * 8, t = row >> 4, c = row & 15; float v[8];
#pragma unroll
        for (int i = 0; i < 8; ++i) { const int k = k8 + i; float x;
            if (k < 512) { const int s = k >> 4, c2 = k & 15; x = (s <= t) ? KM[(t - s) * 256 + c * 16 + c2] : 0.f; }
            else { const int kk = k - 512, pp = kk >> 1, ri = kk & 1; const f32x2 cv = CC[c * 64 + pp], lp = LP[(t + 1) * 64 + pp];
                x = ri ? -(cv.x * lp.y + cv.y * lp.x) : (cv.x * lp.x - cv.y * lp.y); }
            v[i] = x; }
        u32x4 w; w.x = cvt_pk_bf16(v[0], v[1]); w.y = cvt_pk_bf16(v[2], v[3]); w.z = cvt_pk_bf16(v[4], v[5]); w.w = cvt_pk_bf16(v[6], v[7]);
        *(u32x4*)(TZF + (size_t)row * UGLD + k8) = w; }
    __syncthreads();
}

template <bool ADD_YB, bool FINAL, bool WRITE_X, bool DUP = false>
__device__ __forceinline__ void st_prep(const Params& p, const float* Xin, const float* gain, int bid, int nb, int wv) {
    float* X = DUP ? WSP(float, WS_PA) : p.out; bf16_t* HB = DUP ? WSP(bf16_t, WS_SST) : WSP(bf16_t, WS_HB); const bf16_t* YB = WSP(bf16_t, WS_YB);
    const int tid = opaque_tid(wv); const int wave = tid >> 6, lane = tid & 63;
    for (int t = bid * 8 + wave; t < T; t += nb * 8) {
        f32x4 v[4]; float ss = 0.f;
#pragma unroll
        for (int i = 0; i < 4; ++i) { const int c = 4 * (lane + 64 * i); v[i] = *(const f32x4*)(Xin + (size_t)t * D + c);
            if (ADD_YB) { const u32x2 a = *(const u32x2*)(YB + (size_t)t * D + c), b = *(const u32x2*)(YB + ((size_t)T + t) * D + c);
                v[i][0] += bflo(a.x) + bflo(b.x); v[i][1] += bfhi(a.x) + bfhi(b.x); v[i][2] += bflo(a.y) + bflo(b.y); v[i][3] += bfhi(a.y) + bfhi(b.y); }
            ss += v[i][0] * v[i][0] + v[i][1] * v[i][1] + v[i][2] * v[i][2] + v[i][3] * v[i][3]; }
        ss = wave_sum(ss); const float r = rsqrtf(ss / (float)D + EPS);
#pragma unroll
        for (int i = 0; i < 4; ++i) { const int c = 4 * (lane + 64 * i); const f32x4 g = *(const f32x4*)(gain + c); const f32x4 h = v[i] * r * g;
            if (FINAL) *(f32x4*)(X + (size_t)t * D + c) = h;
            else { if (WRITE_X) *(f32x4*)(X + (size_t)t * D + c) = v[i]; u32x2 w; w.x = cvt_pk_bf16(h[0], h[1]); w.y = cvt_pk_bf16(h[2], h[3]); *(u32x2*)(HB + (size_t)t * D + c) = w; } }
    }
}

__device__ __forceinline__ void st_pool(const Params& p, int bid, int nb, int wv) {
    const bf16_t* PA = WSP(bf16_t, WS_PA); bf16_t* YS = WSP(bf16_t, WS_YS);
    const int tid = opaque_tid(wv);
    for (int idx = bid * NTHREADS + tid; idx < (T / 8) * 64; idx += nb * NTHREADS) {
        const int t0 = (idx >> 6) * 8, ch = (idx & 63) * 8, g = ch >> 7, w = 2 << g, pos0 = t0 & (SEQ - 1);
        u32x4 raw[23];
#pragma unroll
        for (int j = 0; j < 23; ++j) { const int dt = j - 15; raw[j] = (pos0 + dt >= 0 && dt >= 1 - w) ? *(const u32x4*)(PA + (size_t)(t0 + dt) * 512 + ch) : (u32x4){0u, 0u, 0u, 0u}; }
#pragma unroll
        for (int i = 0; i < 8; ++i) { const int pos = pos0 + i, cnt = (pos + 1 < w) ? pos + 1 : w; f32x4 s0 = {0.f, 0.f, 0.f, 0.f}, s1 = s0, x0, x1;
            unpack8(raw[15 + i], x0, x1);
#pragma unroll
            for (int j = 0; j < 16; ++j) { if (j < cnt) { f32x4 a0, a1; unpack8(raw[15 + i - j], a0, a1); s0 = s0 + a0; s1 = s1 + a1; } }
            const float inv = 1.0f / (float)cnt;
            *(u32x4*)(YS + (size_t)(t0 + i) * 1536 + ch) = pack8(s0 * inv - x0, s1 * inv - x1); }
    }
}

__device__ __forceinline__ void sgu_unit(const Params& p, const LayerPtrs& L, int unit, LAS unsigned char* lds, int wv) {
    const bf16_t* UV = WSP(bf16_t, WS_UV); bf16_t* YS = WSP(bf16_t, WS_YS); const bf16_t* SGW = WSP(bf16_t, WS_SGW);
    LAS bf16_t* VT = (LAS bf16_t*)lds; LAS float* MU = (LAS float*)(lds + 34816); LAS float* RS = MU + 128;
    const int cb = (unit >> 2) * 128, h = unit & 3; const int tid = opaque_tid(wv), wave = tid >> 6, lane = tid & 63;
    { u32x4 raw[16];
#pragma unroll
      for (int i = 0; i < 16; ++i) raw[i] = *(const u32x4*)(UV + (size_t)(cb + wave * 16 + i) * 1024 + 512 + lane * 8);
#pragma unroll
      for (int i = 0; i < 16; ++i) { f32x4 a0, a1; unpack8(raw[i], a0, a1);
        float sm = (a0[0] + a0[1]) + (a0[2] + a0[3]) + (a1[0] + a1[1]) + (a1[2] + a1[3]);
        float sq = (a0[0] * a0[0] + a0[1] * a0[1]) + (a0[2] * a0[2] + a0[3] * a0[3]) + (a1[0] * a1[0] + a1[1] * a1[1]) + (a1[2] * a1[2] + a1[3] * a1[3]);
        sm = wave_sum(sm); sq = wave_sum(sq); const float mu = sm * (1.0f / 512.0f); const float var = fmaxf(sq * (1.0f / 512.0f) - mu * mu, 0.f);
        if (lane == 0) { MU[wave * 16 + i] = mu; RS[wave * 16 + i] = rsqrtf(var + EPS); } } }
    __syncthreads();
    { const int s_ = tid & 127, cq = tid >> 7; const float mu = MU[s_], rs = RS[s_];
#pragma unroll
        for (int i = 0; i < 4; ++i) { const int c8 = (cq * 4 + i) * 8; f32x4 a0, a1; unpack8(*(const u32x4*)(UV + (size_t)(cb + s_) * 1024 + 512 + h * 128 + c8), a0, a1);
            const f32x4 g0 = *(const f32x4*)(L.ln_g + h * 128 + c8), g1 = *(const f32x4*)(L.ln_g + h * 128 + c8 + 4), b0 = *(const f32x4*)(L.ln_b + h * 128 + c8), b1 = *(const f32x4*)(L.ln_b + h * 128 + c8 + 4);
            a0 = (a0 - mu) * rs * g0 + b0; a1 = (a1 - mu) * rs * g1 + b1;
#pragma unroll
            for (int j = 0; j < 4; ++j) { VT[(c8 + j) * 136 + s_] = f2bf(a0[j]); VT[(c8 + 4 + j) * 136 + s_] = f2bf(a1[j]); } } }
    __syncthreads();
    const int fr = lane & 15, fq = lane >> 4;
    bf16x8 Wf[4];
#pragma unroll
    for (int ks = 0; ks < 4; ++ks) Wf[ks] = *(const bf16x8*)(SGW + ((size_t)h * 128 + wave * 16 + fr) * 128 + ks * 32 + fq * 8);
    const int tl = wave * 16 + fr; const float bias = L.sgu_b[h * 128 + tl];
    const bf16_t* urow = UV + (size_t)(cb + tl) * 1024 + h * 128 + 4 * fq; bf16_t* yrow = YS + (size_t)(cb + tl) * 1536 + 512 + h * 128 + 4 * fq;
    u32x2 uu[8];
#pragma unroll
    for (int n = 0; n < 8; ++n) uu[n] = *(const u32x2*)(urow + n * 16);
#pragma unroll
    for (int n = 0; n < 8; ++n) { f32x4 acc = {0.f, 0.f, 0.f, 0.f};
#pragma unroll
        for (int ks = 0; ks < 4; ++ks) { const bf16x8 Vf = *(const LAS bf16x8*)(VT + (n * 16 + fr) * 136 + ks * 32 + fq * 8); acc = __builtin_amdgcn_mfma_f32_16x16x32_bf16(Vf, Wf[ks], acc, 0, 0, 0); }
        u32x2 o; o.x = cvt_pk_bf16(bflo(uu[n].x) * (acc[0] + bias), bfhi(uu[n].x) * (acc[1] + bias)); o.y = cvt_pk_bf16(bflo(uu[n].y) * (acc[2] + bias), bfhi(uu[n].y) * (acc[3] + bias));
        *(u32x2*)(yrow + n * 16) = o; }
    __syncthreads();
}

__device__ __forceinline__ void scan_unit(const Params& p, const LayerPtrs& L, int g, int pm, int wv) {
    const float* SST = WSP(float, WS_SST); bf16_t* UG = WSP(bf16_t, WS_UG);
    if (wv >= 2) return;
    const int tid = opaque_tid(wv), lane = tid & 63; const int b = 2 * pm + wv;
    const float dt = expf(L.log_dt[g]); const float lre = L.a_re[g * 64 + lane], lim = L.a_im[g * 64 + lane];
    const float er = expf((float)QC * lre * dt); const float qr = er * cosf((float)QC * lim * dt), qi = er * sinf((float)QC * lim * dt);
    float xr = 0.f, xi = 0.f;
    for (int k0 = 0; k0 < SEQ / QC; k0 += 16) { const int n0 = b * (SEQ / QC) + k0; unsigned long long sv[16];
#pragma unroll
        for (int j = 0; j < 16; ++j) sv[j] = __hip_atomic_load((const unsigned long long*)(SST + ((size_t)g * NCH + n0 + j) * 128 + 2 * lane), __ATOMIC_RELAXED, __HIP_MEMORY_SCOPE_AGENT);
#pragma unroll
        for (int j = 0; j < 16; ++j) { *(unsigned*)(UG + ((size_t)g * NCH + n0 + j) * UGLD + 512 + 2 * lane) = cvt_pk_bf16(xr, xi);
            const float sx = __uint_as_float((unsigned)sv[j]), sy = __uint_as_float((unsigned)(sv[j] >> 32));
            const float nr = qr * xr - qi * xi + sx, ni = qr * xi + qi * xr + sy; xr = nr; xi = ni; } }
}

template <bool DUP>
__device__ __forceinline__ void st_route(const Params& p, const LayerPtrs& L, int l, int bid, int nb, LAS unsigned char* lds, int wv) {
    LAS float* RW = (LAS float*)lds; const float* X = p.out; bf16_t* HB = DUP ? WSP(bf16_t, WS_SST) : WSP(bf16_t, WS_HB);
    unsigned* cnt = WSP(unsigned, WS_CTL) + CW_CNT + (l * 32 + (DUP ? 64 : 0)) * CNT_STRIDE; int* LIST = DUP ? WSP(int, WS_PA) : WSP(int, WS_LIST); float* LW = DUP ? WSP(float, WS_PA + 4 * MiB) : WSP(float, WS_LW);
    const int tid = opaque_tid(wv), lane = tid & 63;
#pragma unroll 4
    for (int f = tid; f < 8192; f += NTHREADS) { const int k = f >> 3, n4 = (f & 7) * 4; const f32x4 w = *(const f32x4*)(L.rew + (size_t)f * 4); const float g = L.norm_ffn_g[k];
        LAS float* d = RW + k * 36 + 4 + n4; d[0] = w[0] * g; d[1] = w[1] * g; d[2] = w[2] * g; d[3] = w[3] * g; }
#pragma unroll 2
    for (int f = tid; f < 1024; f += NTHREADS) { const f32x4 w = *(const f32x4*)(L.rgw + (size_t)f * 4); const float g = L.norm_ffn_g[f];
        LAS float* d = RW + f * 36; d[0] = w[0] * g; d[1] = w[1] * g; d[2] = w[2] * g; d[3] = w[3] * g; }
    __syncthreads();
    LAS float* EL = (LAS float*)(lds + 147456 + wv * 1024); LAS float* SS = EL + 128;
    if (wv >= 4) {
        for (int grp = (wv - 4) * nb + bid; grp < T / 16; grp += 4 * nb) {
            for (int i = 0; i < 16; ++i) { const int t = grp * 16 + i; f32x4 v[4]; float ss = 0.f;
#pragma unroll
                for (int c4 = 0; c4 < 4; ++c4) { const int c = 4 * (lane + 64 * c4); v[c4] = *(const f32x4*)(X + (size_t)t * D + c); ss += v[c4][0] * v[c4][0] + v[c4][1] * v[c4][1] + v[c4][2] * v[c4][2] + v[c4][3] * v[c4][3]; }
                ss = wave_sum(ss); const float r = rsqrtf(ss * (1.0f / (float)D) + EPS);
#pragma unroll
                for (int c4 = 0; c4 < 4; ++c4) { const int c = 4 * (lane + 64 * c4); const f32x4 g = *(const f32x4*)(L.norm_ffn_g + c); const f32x4 h = v[c4] * r * g;
                    u32x2 w; w.x = cvt_pk_bf16(h[0], h[1]); w.y = cvt_pk_bf16(h[2], h[3]); *(u32x2*)(HB + (size_t)t * D + c) = w; } } }
    } else
    for (int grp = wv * nb + bid; grp < T / 16; grp += 4 * nb) {
        int ln = lane; asm volatile("" : "+v"(ln));
        const int tl = ln & 15, q = ln >> 4;
        const int t0 = grp * 16; const float* xr = X + (size_t)(t0 + tl) * D + 4 * q;
        f32x4 acc0 = {0.f, 0.f, 0.f, 0.f}, acc1 = acc0, acc2 = acc0; float ss = 0.f;
        f32x4 xa[16];
#pragma unroll
        for (int i = 0; i < 16; ++i) xa[i] = *(const f32x4*)(xr + i * 16);
        const int tl2 = 32 + (tl & 3);
#pragma unroll 1
        for (int kc = 0; kc < 4; ++kc) { const float* xn = xr + (kc < 3 ? kc + 1 : 3) * 256; const LAS float* wk = RW + (kc * 256 + 4 * q) * 36;
#pragma unroll
            for (int i = 0; i < 16; ++i) { const f32x4 xv = xa[i];
                xa[i] = *(const f32x4*)(xn + i * 16);
                ss += xv[0] * xv[0] + xv[1] * xv[1] + xv[2] * xv[2] + xv[3] * xv[3];
#pragma unroll
                for (int j = 0; j < 4; ++j) { const LAS float* wrow = wk + (i * 16 + j) * 36;
                    acc0 = __builtin_amdgcn_mfma_f32_16x16x4f32(xv[j], wrow[tl], acc0, 0, 0, 0);
                    acc1 = __builtin_amdgcn_mfma_f32_16x16x4f32(xv[j], wrow[tl + 16], acc1, 0, 0, 0);
                    acc2 = __builtin_amdgcn_mfma_f32_16x16x4f32(xv[j], wrow[tl2], acc2, 0, 0, 0); } } }
        SS[lane] = ss; asm volatile("s_waitcnt lgkmcnt(0)" ::: "memory");
        float rs[4];
#pragma unroll
        for (int r = 0; r < 4; ++r) { const int tok = 4 * q + r; rs[r] = rsqrtf(((SS[tok] + SS[tok + 16]) + (SS[tok + 32] + SS[tok + 48])) * (1.0f / (float)D) + EPS); }
        asm volatile("s_waitcnt lgkmcnt(0)" ::: "memory");
        const float bias0 = (tl < 4) ? L.rgb[tl] : L.reb[tl - 4], bias1 = L.reb[tl + 12], bias2 = (tl < 4) ? L.reb[tl + 28] : 0.f;
        float v0[4], v1[4], v2[4];
#pragma unroll
        for (int r = 0; r < 4; ++r) { v0[r] = acc0[r] * rs[r] + bias0; v1[r] = acc1[r] * rs[r] + bias1; v2[r] = acc2[r] * rs[r] + bias2; }
        LAS float* GL = SS;
        if (tl < 4) {
#pragma unroll
            for (int r = 0; r < 4; ++r) GL[(4 * q + r) * 4 + tl] = v0[r]; }
        asm volatile("s_waitcnt lgkmcnt(0)" ::: "memory");
#pragma unroll
        for (int r = 0; r < 4; ++r) { const int tok = 4 * q + r; const f32x4 g4 = *(const LAS f32x4*)(GL + tok * 4);
            int gi = 0; float gm = g4[0]; if (g4[1] > gm) { gm = g4[1]; gi = 1; } if (g4[2] > gm) { gm = g4[2]; gi = 2; } if (g4[3] > gm) { gm = g4[3]; gi = 3; }
            const int lo = 4 + 8 * gi; int j;
            j = tl - lo; if (j >= 0 && j < 8) EL[tok * 8 + j] = v0[r];
            j = tl + 16 - lo; if (j >= 0 && j < 8) EL[tok * 8 + j] = v1[r];
            j = tl + 32 - lo; if (j >= 0 && j < 8 && tl < 4) EL[tok * 8 + j] = v2[r]; }
        asm volatile("s_waitcnt lgkmcnt(0)" ::: "memory");
        if (lane < 32) { const int tok = lane & 15, slot = lane >> 4; const f32x4 g4 = *(const LAS f32x4*)(GL + tok * 4);
            int gi = 0; float gm = g4[0]; if (g4[1] > gm) { gm = g4[1]; gi = 1; } if (g4[2] > gm) { gm = g4[2]; gi = 2; } if (g4[3] > gm) { gm = g4[3]; gi = 3; }
            const float gval = 1.0f / (expf(g4[0] - gm) + expf(g4[1] - gm) + expf(g4[2] - gm) + expf(g4[3] - gm));
            const f32x4 ea = *(const LAS f32x4*)(EL + tok * 8), eb = *(const LAS f32x4*)(EL + tok * 8 + 4);
            float el[8] = {ea[0], ea[1], ea[2], ea[3], eb[0], eb[1], eb[2], eb[3]};
            int i0 = 0; float e0 = el[0];
#pragma unroll
            for (int j = 1; j < 8; ++j) if (el[j] > e0) { e0 = el[j]; i0 = j; }
            int i1 = -1; float e1 = -INFINITY;
#pragma unroll
            for (int j = 0; j < 8; ++j) if (j != i0 && el[j] > e1) { e1 = el[j]; i1 = j; }
            const float ex = expf(e1 - e0); const float w0 = gval / (1.f + ex), w1 = gval * ex / (1.f + ex);
            const int e = gi * 8 + (slot == 0 ? i0 : i1); const unsigned pos = atomicAdd(cnt + e * CNT_STRIDE, 1u);
            LIST[(size_t)e * CAP + pos] = (t0 + tok) * 2 + slot; LW[(size_t)e * CAP + pos] = slot == 0 ? w0 : w1; }
        asm volatile("s_waitcnt lgkmcnt(0)" ::: "memory");
    }
    __syncthreads();
}

namespace tw {
__device__ __forceinline__ float dot_bf16(const bf16_t* a, const bf16_t* b, int K) { float s = 0.f;
    for (int k = 0; k < K; k += 8) { f32x4 a0, a1, b0, b1; unpack8(*(const u32x4*)(a + k), a0, a1); unpack8(*(const u32x4*)(b + k), b0, b1);
        s += a0[0] * b0[0] + a0[1] * b0[1] + a0[2] * b0[2] + a0[3] * b0[3] + a1[0] * b1[0] + a1[1] * b1[1] + a1[2] * b1[2] + a1[3] * b1[3]; } return s; }
__global__ void __launch_bounds__(256) inproj(Params p, int l) {
    const LayerPtrs L = layer_ptrs(p, l); const int t = blockIdx.y, c = blockIdx.x * 256 + threadIdx.x;
    const float a = dot_bf16(WSP(bf16_t, WS_HB) + (size_t)t * 1024, WSP(bf16_t, WS_WIN) + (size_t)c * 1024, 1024);
    if (c < 512) WSP(bf16_t, WS_PA)[(size_t)t * 512 + c] = f2bf(a);
    else if (c < 1536) WSP(bf16_t, WS_UV)[(size_t)t * 1024 + c - 512] = f2bf(gelu_tanh_ref(a));
    else if (c < 2048) { const int cs = c - 1536, g = cs >> 4, cc = cs & 15, n = t >> 5, s = t & 31; WSP(bf16_t, WS_UG)[((size_t)g * NCH + n) * UGLD + s * 16 + cc] = f2bf(a); }
    else WSP(bf16_t, WS_GATES)[(size_t)t * 3072 + c - 2048] = f2bf(1.0f / (1.0f + expf(-(a + L.b_gate[c - 2048]))));
}
__global__ void __launch_bounds__(256) sgu_stats(Params p) {
    __shared__ float sh[8]; const int t = blockIdx.x; const bf16_t* UV = WSP(bf16_t, WS_UV); float* ST = WSP(float, WS_MERGED);
    const float a = bf2f(UV[(size_t)t * 1024 + 512 + threadIdx.x]), b = bf2f(UV[(size_t)t * 1024 + 768 + threadIdx.x]);
    float s = a + b; for (int o = 32; o >= 1; o >>= 1) s += __shfl_xor(s, o); __syncthreads(); if ((threadIdx.x & 63) == 0) sh[threadIdx.x >> 6] = s; __syncthreads(); const float mu = (sh[0] + sh[1] + sh[2] + sh[3]) / 512.f;
    float q = (a - mu) * (a - mu) + (b - mu) * (b - mu); for (int o = 32; o >= 1; o >>= 1) q += __shfl_xor(q, o); __syncthreads(); if ((threadIdx.x & 63) == 0) sh[threadIdx.x >> 6] = q; __syncthreads();
    if (threadIdx.x == 0) { ST[2 * t] = mu; ST[2 * t + 1] = rsqrtf((sh[0] + sh[1] + sh[2] + sh[3]) / 512.f + EPS); }
}
__global__ void __launch_bounds__(256) sgu_mix(Params p, int l) {
    const LayerPtrs L = layer_ptrs(p, l); const bf16_t* UV = WSP(bf16_t, WS_UV); const float* ST = WSP(float, WS_MERGED); bf16_t* YS = WSP(bf16_t, WS_YS);
    const int idx = blockIdx.x * 256 + threadIdx.x; const int t = idx >> 9, ch = idx & 511, h = ch >> 7, tl = t & 127, cb = t - tl; float s = 0.f;
    for (int sp = 0; sp <= tl; ++sp) { const float v = (bf2f(UV[(size_t)(cb + sp) * 1024 + 512 + ch]) - ST[2 * (cb + sp)]) * ST[2 * (cb + sp) + 1] * L.ln_g[ch] + L.ln_b[ch];
        s += L.sgu_w[((size_t)h * 128 + tl) * 128 + sp] * v; }
    s += L.sgu_b[h * 128 + tl];
    YS[(size_t)t * 1536 + 512 + ch] = f2bf(bf2f(UV[(size_t)t * 1024 + ch]) * s);
}
__global__ void __launch_bounds__(64) ssm(Params p, int l) {
    const LayerPtrs L = layer_ptrs(p, l); const bf16_t* UG = WSP(bf16_t, WS_UG); bf16_t* YG = WSP(bf16_t, WS_YG);
    const int b = blockIdx.x >> 5, g = blockIdx.x & 31, pp = threadIdx.x;
    const float lre = L.a_re[g * 64 + pp], lim = L.a_im[g * 64 + pp], dt = expf(L.log_dt[g]);
    const float er = expf(lre * dt); const float lbr = er * cosf(lim * dt), lbi = er * sinf(lim * dt);
    const float nr = lbr - 1.f, ni = lbi, den = lre * lre + lim * lim; const float cr = (nr * lre + ni * lim) / den, ci = (ni * lre - nr * lim) / den;
    float bbr[16], bbi[16], ccr[16], cci[16];
#pragma unroll
    for (int c = 0; c < 16; ++c) { const float br = L.b_re[(g * 64 + pp) * 16 + c], bi = L.b_im[(g * 64 + pp) * 16 + c]; bbr[c] = cr * br - ci * bi; bbi[c] = cr * bi + ci * br;
        ccr[c] = L.c_re[(g * 16 + c) * 64 + pp]; cci[c] = L.c_im[(g * 16 + c) * 64 + pp]; }
    const float dsk = L.ssm_d[g * 16 + (pp & 15)]; float xr = 0.f, xi = 0.f;
    for (int t = 0; t < SEQ; ++t) { const int tok = b * SEQ + t, n = tok >> 5, s = tok & 31; const bf16_t* row = UG + ((size_t)g * NCH + n) * UGLD + s * 16;
        float u[16];
#pragma unroll
        for (int c = 0; c < 16; ++c) u[c] = bf2f(row[c]);
        float bur = 0.f, bui = 0.f;
#pragma unroll
        for (int c = 0; c < 16; ++c) { bur += bbr[c] * u[c]; bui += bbi[c] * u[c]; }
        const float nxr = lbr * xr - lbi * xi + bur, nxi = lbr * xi + lbi * xr + bui; xr = nxr; xi = nxi; float yout = 0.f;
#pragma unroll
        for (int c = 0; c < 16; ++c) { float v = xr * ccr[c] - xi * cci[c]; for (int o = 32; o >= 1; o >>= 1) v += __shfl_xor(v, o); if (pp == c) yout = v + dsk * u[c]; }
        if (pp < 16) YG[(size_t)tok * 512 + g * 16 + pp] = f2bf(gelu_tanh_ref(yout)); }
}
__global__ void __launch_bounds__(256) glu(Params p, int l) {
    const LayerPtrs L = layer_ptrs(p, l); const int t = blockIdx.y, c = blockIdx.x * 256 + threadIdx.x; const bf16_t* YG = WSP(bf16_t, WS_YG);
    const float z = dot_bf16(YG + (size_t)t * 512, WSP(bf16_t, WS_GLU) + (size_t)c * 512, 512) + L.glu_b[c];
    WSP(bf16_t, WS_YS)[(size_t)t * 1536 + 1024 + c] = f2bf(bf2f(YG[(size_t)t * 512 + c]) / (1.0f + expf(-z)));
}
__global__ void __launch_bounds__(256) branch(Params p) {
    const int t = blockIdx.y, c = blockIdx.x * 256 + threadIdx.x; const bf16_t* YS = WSP(bf16_t, WS_YS) + (size_t)t * 1536; const bf16_t* WB = WSP(bf16_t, WS_WB) + (size_t)c * 1536; const bf16_t* G = WSP(bf16_t, WS_GATES) + (size_t)t * 3072;
    float s = 0.f;
    for (int k = 0; k < 3; ++k) s += bf2f(G[k * 1024 + c]) * dot_bf16(YS + k * 512, WB + k * 512, 512);
    WSP(bf16_t, WS_MERGED)[(size_t)t * 1024 + c] = f2bf(s);
}
__global__ void __launch_bounds__(256) wout(Params p) {
    const int t = blockIdx.y, c = blockIdx.x * 256 + threadIdx.x;
    p.out[(size_t)t * 1024 + c] += dot_bf16(WSP(bf16_t, WS_MERGED) + (size_t)t * 1024, WSP(bf16_t, WS_WOUT) + (size_t)c * 1024, 1024);
}
__global__ void __launch_bounds__(256) moe(Params p, int l) {
    __shared__ float act[512];
    const int e = blockIdx.y, pos = blockIdx.x; const unsigned n = WSP(unsigned, WS_CTL)[CW_CNT + (l * 32 + e) * CNT_STRIDE]; if ((unsigned)pos >= n) return;
    const int idx = WSP(int, WS_LIST)[(size_t)e * CAP + pos]; const float w = WSP(float, WS_LW)[(size_t)e * CAP + pos]; const int tok = idx >> 1, slot = idx & 1;
    const bf16_t* h = WSP(bf16_t, WS_HB) + (size_t)tok * 1024; const bf16_t* WGU = WSP(bf16_t, WS_WGU) + (size_t)e * 1024 * 1024; const bf16_t* WD = WSP(bf16_t, WS_WD) + (size_t)e * 1024 * 512;
    for (int j = threadIdx.x; j < 512; j += 256) { const int pn = j >> 7, jj = j & 127; const float g = dot_bf16(h, WGU + (size_t)(256 * pn + jj) * 1024, 1024), u = dot_bf16(h, WGU + (size_t)(256 * pn + 128 + jj) * 1024, 1024);
        act[j] = bf2f(f2bf(w * (g / (1.0f + expf(-g))) * u)); }
    __syncthreads();
    for (int d = threadIdx.x; d < 1024; d += 256) { float s = 0.f; const bf16_t* wr = WD + (size_t)d * 512; for (int k = 0; k < 512; ++k) s += act[k] * bf2f(wr[k]);
        WSP(bf16_t, WS_YB)[((size_t)slot * T + tok) * 1024 + d] = f2bf(s); }
}
}

enum { ST_CONV = 0, ST_PREP, ST_INPROJ, ST_MIXA, ST_SCAN, ST_SSMOUT, ST_GLU, ST_BRANCH, ST_WOUT, ST_ROUTE, ST_MOE1, ST_MOE2, ST_FINAL, ST_POOL, ST_SGU, ST_SST };

template <int STAGE, bool DUP = false>
__device__ __forceinline__ void run_stage(const Params& p_arg, int l, int bid, int nb, LAS unsigned char* lds, int wv) {
    asm volatile("" : "+s"(l));
    Params p;
#if defined(__HIP_DEVICE_COMPILE__)
    typedef const Params __attribute__((address_space(4))) KParams;
    const KParams* kp = (const KParams*)__builtin_amdgcn_kernarg_segment_ptr(); asm volatile("" : "+s"(kp));
#pragma unroll
    for (int i = 0; i < 31; ++i) p.in[i] = kp->in[i];
    p.out = kp->out; p.ws = kp->ws; (void)p_arg;
#else
    p = p_arg;
#endif
    const LayerPtrs L = layer_ptrs(p, l);
    if constexpr (STAGE == ST_CONV) st_conv(p, l, bid, nb, lds, wv);
    if constexpr (STAGE == ST_PREP) { if (l == 0) st_prep<false, false, true, DUP>(p, p.in[0], L.norm_mix_g, bid, nb, wv); else st_prep<true, false, true, DUP>(p, p.out, L.norm_mix_g, bid, nb, wv); }
    if constexpr (STAGE == ST_FINAL) st_prep<true, true, false, DUP>(p, p.out, p.in[30], bid, nb, wv);
    if constexpr (STAGE == ST_INPROJ) { pg8::DenseOrder S; S.init(WSP(bf16_t, WS_HB), 1024, WSP(bf16_t, WS_WIN), 1024, T, INC, 1024, nb, bid);
        EpiInProj E{WSP(bf16_t, WS_PA), WSP(bf16_t, WS_UV), WSP(bf16_t, WS_UG), WSP(bf16_t, WS_GATES), L.b_gate}; pg8::gemm_phase(lds, S, E, wv); }
    if constexpr (STAGE == ST_SST) { pg8::GroupOrder S; S.init(WSP(bf16_t, WS_UG), (size_t)NCH * UGLD * 2, UGLD, WSP(bf16_t, WS_ET), (size_t)256 * 512 * 2, 512, 32, NCH, 256, 512, nb, bid);
        EpiSst E{WSP(float, WS_SST)}; pg8::gemm_phase(lds, S, E, wv);
        for (int u = bid; u < 64; u += nb) scan_unit(p, L, u >> 1, u & 1, wv); }
    if constexpr (STAGE == ST_POOL) st_pool(p, bid, nb, wv);
    if constexpr (STAGE == ST_SGU) { for (int u = bid; u < 512; u += nb) sgu_unit(p, L, u, lds, wv); }
    if constexpr (STAGE == ST_SSMOUT) { pg8::GroupOrder S; S.init(WSP(bf16_t, WS_UG), (size_t)NCH * UGLD * 2, UGLD, WSP(bf16_t, WS_TZF), (size_t)512 * UGLD * 2, UGLD, 32, NCH, 512, UGLD, nb, bid);
        EpiSsmOut E{WSP(bf16_t, WS_YG)}; pg8::gemm_phase(lds, S, E, wv); }
    if constexpr (STAGE == ST_GLU) { pg8::DenseOrder S; S.init(WSP(bf16_t, WS_YG), 512, WSP(bf16_t, WS_GLU), 512, T, 512, 512, nb, bid);
        EpiGlu E{WSP(bf16_t, WS_YG), WSP(bf16_t, WS_YS), L.glu_b}; pg8::gemm_phase(lds, S, E, wv); }
    if constexpr (STAGE == ST_BRANCH) { pg8::DenseOrder S; S.init(WSP(bf16_t, WS_YS), 1536, WSP(bf16_t, WS_WB), 1536, T, 1024, 512, nb, bid, 3);
        EpiBranch E{WSP(bf16_t, WS_GATES), WSP(bf16_t, WS_MERGED)}; pg8::gemm_phase(lds, S, E, wv); }
    if constexpr (STAGE == ST_WOUT) { pg8::DenseOrder S; S.init(WSP(bf16_t, WS_MERGED), 1024, WSP(bf16_t, WS_WOUT), 1024, T, 1024, 1024, nb, bid);
        EpiWout E{DUP ? WSP(float, WS_PA) : p.out}; pg8::gemm_phase(lds, S, E, wv); }
    if constexpr (STAGE == ST_ROUTE) st_route<DUP>(p, L, l, bid, nb, lds, wv);
    if constexpr (STAGE == ST_MOE1) { const int tid = opaque_tid(wv); LAS unsigned* tab = (LAS unsigned*)(lds + 131072); pg8::moe_table(tab, WSP(unsigned, WS_CTL) + CW_CNT + l * 32 * CNT_STRIDE, tid);
        pg8::MoeOrder<true> S{(const char*)WSP(bf16_t, WS_HB), (const char*)WSP(bf16_t, WS_WGU), (size_t)1024 * 1024 * 2, 1024, 1024, 1024, 4, nb, bid, tab, WSP(int, WS_LIST), tid & 63};
        EpiMoe1 E{WSP(bf16_t, WS_ACT), WSP(float, WS_LW)}; pg8::gemm_phase(lds, S, E, wv); }
    if constexpr (STAGE == ST_MOE2) { const int tid = opaque_tid(wv); LAS unsigned* tab = (LAS unsigned*)(lds + 131072); pg8::moe_table(tab, WSP(unsigned, WS_CTL) + CW_CNT + l * 32 * CNT_STRIDE, tid);
        pg8::MoeOrder<false> S{(const char*)WSP(bf16_t, WS_ACT), (const char*)WSP(bf16_t, WS_WD), (size_t)1024 * 512 * 2, 512, 512, 512, 4, nb, bid, tab, WSP(int, WS_LIST), tid & 63};
        EpiMoe2 E{WSP(bf16_t, WS_YB), WSP(int, WS_LIST)}; pg8::gemm_phase(lds, S, E, wv); }
}

template <int STAGE>
__global__ void __launch_bounds__(NTHREADS, 2) k_stage(Params p, int l) {
    extern __shared__ __attribute__((aligned(16))) unsigned char lds_raw[];
    run_stage<STAGE>(p, l, (int)blockIdx.x, (int)gridDim.x, (LAS unsigned char*)lds_raw, __builtin_amdgcn_readfirstlane((int)threadIdx.x >> 6));
}


__global__ void __launch_bounds__(NTHREADS, 2) k_mega(Params p) {
    extern __shared__ __attribute__((aligned(16))) unsigned char lds_raw[];
    LAS unsigned char* lds = (LAS unsigned char*)lds_raw;
    volatile LAS unsigned* xbw = (volatile LAS unsigned*)(lds + LDS_BYTES - 16);
    if (threadIdx.x < 4) xbw[threadIdx.x] = 0u;
    const int bid = (int)blockIdx.x, nb = (int)gridDim.x, wv = __builtin_amdgcn_readfirstlane((int)threadIdx.x >> 6);
    __syncthreads();
    XcdBarrier bar = xcd_barrier_post(WSP(unsigned, WS_CTL) + CW_BAR, xbw, wv);
#define RUN_(ST, l) do { run_stage<ST>(p, l, bid, nb, lds, wv); if ((DBL_MASK >> ST) & 1u) run_stage<ST, true>(p, l, bid, nb, lds, wv); } while (0)
#define MK_LAYER(l) do { \
        RUN_(ST_CONV, l); RUN_(ST_PREP, l); xcd_barrier(bar); \
        RUN_(ST_INPROJ, l); xcd_barrier(bar); \
        RUN_(ST_SST, l); RUN_(ST_POOL, l); RUN_(ST_SGU, l); xcd_barrier(bar); \
        RUN_(ST_SSMOUT, l); xcd_barrier(bar); \
        RUN_(ST_GLU, l); xcd_barrier(bar); \
        RUN_(ST_BRANCH, l); xcd_barrier(bar); \
        RUN_(ST_WOUT, l); xcd_barrier(bar); \
        RUN_(ST_ROUTE, l); xcd_barrier(bar); \
        RUN_(ST_MOE1, l); xcd_barrier(bar); \
        RUN_(ST_MOE2, l); xcd_barrier(bar); \
    } while (0)
    MK_LAYER(0);
    MK_LAYER(1);
#undef MK_LAYER
    if ((DBL_MASK >> ST_FINAL) & 1u) run_stage<ST_FINAL, true>(p, 0, bid, nb, lds, wv);
    run_stage<ST_FINAL>(p, 0, bid, nb, lds, wv);
}

template <int STAGE> static void launch_stage(const Params& p, int l, int grid, hipStream_t stream) {
    static bool attr = false;
    if (!attr) { (void)hipFuncSetAttribute((const void*)k_stage<STAGE>, hipFuncAttributeMaxDynamicSharedMemorySize, LDS_BYTES); attr = true; }
    hipLaunchKernelGGL(k_stage<STAGE>, dim3(grid), dim3(NTHREADS), LDS_BYTES, stream, p, l);
}
#define FAST(s) ((FAST_MASK >> (s)) & 1u)

extern "C" void kernel_launch(void* const* d_in, const int* in_sizes, int n_in, void* d_out, int out_size, void* d_ws, size_t ws_size, hipStream_t stream) {
    if (n_in != 31 || out_size != T * D || ws_size < WS_END) { fprintf(stderr, "kernel_launch: unexpected shapes (n_in %d out %d ws %zu need %zu)\n", n_in, out_size, ws_size, (size_t)WS_END); return; }
    Params p{};
    for (int i = 0; i < 31; ++i) p.in[i] = (const float*)d_in[i];
    p.out = (float*)d_out; p.ws = (unsigned char*)d_ws;
    (void)hipMemsetAsync((char*)d_ws + WS_CTL, 0, 1 * MiB, stream);
#if ONE_LAUNCH
    static int grid = 0;
    if (!grid) {
        int dev = 0, cus = 0, per_cu = 0;
        (void)hipGetDevice(&dev); (void)hipDeviceGetAttribute(&cus, hipDeviceAttributeMultiprocessorCount, dev);
        (void)hipFuncSetAttribute((const void*)k_mega, hipFuncAttributeMaxDynamicSharedMemorySize, LDS_BYTES);
        if (hipOccupancyMaxActiveBlocksPerMultiprocessor(&per_cu, (const void*)k_mega, NTHREADS, LDS_BYTES) != hipSuccess || per_cu < 1) { fprintf(stderr, "kernel_launch: occupancy query says %d blocks per CU\n", per_cu); (void)hipGetLastError(); }
        grid = cus > 0 ? cus : 256;
    }
    hipLaunchKernelGGL(k_mega, dim3(grid), dim3(NTHREADS), LDS_BYTES, stream, p);
    return;
#endif
    const int G = 256;
    for (int l = 0; l < 2; ++l) {
        launch_stage<ST_CONV>(p, l, G, stream);
        launch_stage<ST_PREP>(p, l, G, stream);
        if (FAST(ST_INPROJ)) launch_stage<ST_INPROJ>(p, l, G, stream); else tw::inproj<<<dim3(INC / 256, T), 256, 0, stream>>>(p, l);
        launch_stage<ST_POOL>(p, l, G, stream);
        if (FAST(ST_SGU)) launch_stage<ST_SGU>(p, l, G, stream); else { tw::sgu_stats<<<T, 256, 0, stream>>>(p); tw::sgu_mix<<<T * 512 / 256, 256, 0, stream>>>(p, l); }
        if (FAST(ST_SSMOUT)) { launch_stage<ST_SST>(p, l, G, stream); launch_stage<ST_SSMOUT>(p, l, G, stream); }
        else tw::ssm<<<128, 64, 0, stream>>>(p, l);
        if (FAST(ST_GLU)) launch_stage<ST_GLU>(p, l, G, stream); else tw::glu<<<dim3(2, T), 256, 0, stream>>>(p, l);
        if (FAST(ST_BRANCH)) launch_stage<ST_BRANCH>(p, l, G, stream); else tw::branch<<<dim3(4, T), 256, 0, stream>>>(p);
        if (FAST(ST_WOUT)) launch_stage<ST_WOUT>(p, l, G, stream); else tw::wout<<<dim3(4, T), 256, 0, stream>>>(p);
        launch_stage<ST_ROUTE>(p, l, G, stream);
        if (FAST(ST_MOE1)) { launch_stage<ST_MOE1>(p, l, G, stream); launch_stage<ST_MOE2>(p, l, G, stream); }
        else tw::moe<<<dim3(8192, 32), 256, 0, stream>>>(p, l);
    }
    launch_stage<ST_FINAL>(p, 0, G, stream);
}
```
